# Optimizing an MI355X kernel written in HIP

```python
import math
import jax, jax.numpy as jnp
from jax import lax
import numpy as np

D_MODEL = 2048
BATCH = 8
SEQ = 2048
DEPTH = 1

GRID_W = 64
CTX_LEN = 256
HEAD_DIM = 128
N_Q_HEADS = 8
N_KV_HEADS = 2
GQA_GROUP = N_Q_HEADS // N_KV_HEADS
ATTN_WIDTH = N_Q_HEADS * HEAD_DIM
KV_WIDTH = N_KV_HEADS * HEAD_DIM
Q_BLOCK = 128
ROPE_THETA = 10000.0
ROPE_AXIS_DIM = HEAD_DIM // 2
ROPE_FREQS = ROPE_AXIS_DIM // 2
F_GROUPS = 4
F_GROUP_DIM = 256
FOURIER_WIDTH = F_GROUPS * F_GROUP_DIM
MIX_WIDTH = ATTN_WIDTH + FOURIER_WIDTH
IN_PROJ_WIDTH = ATTN_WIDTH + 2 * KV_WIDTH + FOURIER_WIDTH
PEER_HEADS = 8
N_KEYS = 128
N_EXPERTS = N_KEYS * N_KEYS
D_KEY = 256
D_KEY_HALF = D_KEY // 2
TOPK_HALF = 16
TOPK = 16
PEER_BLOCK = 128
N_MOD = 6
EPS = 1e-6

kernel_name = "hymba_fnet_peer_dit_layer"


def rms_norm(x, g):
    xf = x.astype(jnp.float32)
    y = xf * lax.rsqrt(jnp.mean(xf * xf, axis=-1, keepdims=True) + EPS)
    return (y * g.astype(jnp.float32)).astype(x.dtype)


def modulate(h, shift, scale):
    return h * (1.0 + scale) + shift


def rope_tables(length):
    rows = length // GRID_W
    row = jnp.broadcast_to(jnp.arange(rows)[:, None], (rows, GRID_W)).reshape(-1)
    col = jnp.broadcast_to(jnp.arange(GRID_W)[None, :], (rows, GRID_W)).reshape(-1)
    inv_freq = ROPE_THETA ** (-jnp.arange(ROPE_FREQS, dtype=jnp.float32) / ROPE_FREQS)
    ang_row = row.astype(jnp.float32)[:, None] * inv_freq
    ang_col = col.astype(jnp.float32)[:, None] * inv_freq
    return ang_row, ang_col


def _rotate(xp, ang):
    c = jnp.cos(ang)[None, :, None, :].astype(xp.dtype)
    s = jnp.sin(ang)[None, :, None, :].astype(xp.dtype)
    x1, x2 = jnp.split(xp, 2, axis=-1)
    return jnp.concatenate([x1 * c - x2 * s, x2 * c + x1 * s], axis=-1)


def axial_rope(x, ang_row, ang_col):
    return jnp.concatenate([_rotate(x[..., :ROPE_AXIS_DIM], ang_row),
                            _rotate(x[..., ROPE_AXIS_DIM:], ang_col)], axis=-1)


def project(h, w_in, g_q, g_k):
    B, L, _ = h.shape
    p = h @ w_in
    q = p[..., :ATTN_WIDTH].reshape(B, L, N_Q_HEADS, HEAD_DIM)
    k = p[..., ATTN_WIDTH:ATTN_WIDTH + KV_WIDTH].reshape(B, L, N_KV_HEADS, HEAD_DIM)
    v = p[..., ATTN_WIDTH + KV_WIDTH:ATTN_WIDTH + 2 * KV_WIDTH].reshape(B, L, N_KV_HEADS, HEAD_DIM)
    f = p[..., ATTN_WIDTH + 2 * KV_WIDTH:]
    return rms_norm(q, g_q), rms_norm(k, g_k), v, f


def attend(q, k, v):
    B, Lq = q.shape[0], q.shape[1]
    nb = Lq // Q_BLOCK
    qb = (q * (HEAD_DIM ** -0.5)).reshape(B, nb, Q_BLOCK, N_KV_HEADS, GQA_GROUP, HEAD_DIM)
    qb = jnp.moveaxis(qb, 1, 0)

    def block(qi):
        s = jnp.einsum('bqgrd,bkgd->bgrqk', qi, k).astype(jnp.float32)
        p = jax.nn.softmax(s, axis=-1).astype(v.dtype)
        return jnp.einsum('bgrqk,bkgd->bqgrd', p, v)

    o = lax.map(block, qb)
    return jnp.moveaxis(o, 0, 1).reshape(B, Lq, ATTN_WIDTH)


def fourier_mix(f, w_f, b_f):
    B, L, _ = f.shape
    fg = f.reshape(B, L, F_GROUPS, F_GROUP_DIM).astype(jnp.float32)
    spec = jnp.fft.fft2(fg, axes=(1, 3), norm="ortho").real.astype(f.dtype)
    y = jnp.einsum('blgc,gcd->blgd', spec, w_f) + b_f.reshape(F_GROUPS, F_GROUP_DIM)
    return y.reshape(B, L, FOURIER_WIDTH)


def peer(h, w_query, sub_keys, u_exp, v_exp):
    B, L, D = h.shape
    hb = h.reshape(-1, PEER_BLOCK, D)

    def block(xb):
        q = (xb @ w_query).reshape(PEER_BLOCK, PEER_HEADS, 2, D_KEY_HALF)
        s = jnp.einsum('thpd,hpkd->thpk', q, sub_keys).astype(jnp.float32)
        s_top, i_top = lax.top_k(s, TOPK_HALF)
        cand = (s_top[:, :, 0, :, None] + s_top[:, :, 1, None, :]).reshape(
            PEER_BLOCK, PEER_HEADS, TOPK_HALF * TOPK_HALF)
        cand_idx = (i_top[:, :, 0, :, None] * N_KEYS + i_top[:, :, 1, None, :]).reshape(
            PEER_BLOCK, PEER_HEADS, TOPK_HALF * TOPK_HALF)
        s_fin, j = lax.top_k(cand, TOPK)
        idx = jnp.take_along_axis(cand_idx, j, axis=-1)
        g = jax.nn.softmax(s_fin, axis=-1)
        u_sel = u_exp[idx]
        a = jax.nn.gelu(jnp.einsum('td,thkd->thk', xb, u_sel), approximate=False)
        w = (g * a.astype(jnp.float32)).astype(xb.dtype)
        v_sel = v_exp[idx]
        return jnp.einsum('thk,thkd->td', w, v_sel)

    return lax.map(block, hb).reshape(B, L, D)


def setup_inputs(seed: int = 0) -> dict:
    key = jax.random.key(seed)
    ks = jax.random.split(key, 20)
    f32 = jnp.float32
    D = D_MODEL

    def nrm(k, shape, scale):
        return jax.random.normal(k, shape, f32) * scale

    return {
        "x": nrm(ks[0], (BATCH, SEQ, D), 1.0),
        "c": nrm(ks[1], (BATCH, D), 1.0),
        "ctx": nrm(ks[2], (BATCH, CTX_LEN, D), 1.0),
        "c_ctx": nrm(ks[3], (D,), 1.0),
        "w_ada": nrm(ks[4], (DEPTH, D, N_MOD * D), 0.5 * D ** -0.5),
        "b_ada": nrm(ks[5], (DEPTH, N_MOD * D), 0.02),
        "g_norm1": 1.0 + nrm(ks[6], (DEPTH, D), 0.02),
        "w_in": nrm(ks[7], (DEPTH, D, IN_PROJ_WIDTH), D ** -0.5),
        "g_q": 1.0 + nrm(ks[8], (DEPTH, HEAD_DIM), 0.02),
        "g_k": 1.0 + nrm(ks[9], (DEPTH, HEAD_DIM), 0.02),
        "w_fourier": nrm(ks[10], (DEPTH, F_GROUPS, F_GROUP_DIM, F_GROUP_DIM), F_GROUP_DIM ** -0.5),
        "b_fourier": nrm(ks[11], (DEPTH, FOURIER_WIDTH), 0.02),
        "w_out": nrm(ks[12], (DEPTH, MIX_WIDTH, D), MIX_WIDTH ** -0.5),
        "g_norm2": 1.0 + nrm(ks[13], (DEPTH, D), 0.02),
        "w_query": nrm(ks[14], (DEPTH, D, PEER_HEADS * D_KEY), D ** -0.5),
        "sub_keys": nrm(ks[15], (DEPTH, PEER_HEADS, 2, N_KEYS, D_KEY_HALF), D_KEY_HALF ** -0.5),
        "u_experts": nrm(ks[16], (DEPTH, N_EXPERTS, D), D ** -0.5),
        "v_experts": nrm(ks[17], (DEPTH, N_EXPERTS, D), 0.5),
        "g_final": 1.0 + nrm(ks[18], (D,), 0.02),
    }


def reference(x, c, ctx, c_ctx, w_ada, b_ada, g_norm1, w_in, g_q, g_k, w_fourier, b_fourier,
              w_out, g_norm2, w_query, sub_keys, u_experts, v_experts, g_final):
    L = x.shape[1]
    ang_row, ang_col = rope_tables(L)
    xl, xc = x, ctx
    for layer in range(DEPTH):
        mod_l = jax.nn.silu(c) @ w_ada[layer] + b_ada[layer]
        mod_c = jax.nn.silu(c_ctx) @ w_ada[layer] + b_ada[layer]
        sh1, sc1, gt1, sh2, sc2, gt2 = [m[:, None, :] for m in jnp.split(mod_l, N_MOD, axis=-1)]
        csh1, csc1, cgt1, csh2, csc2, cgt2 = jnp.split(mod_c, N_MOD, axis=-1)

        hl = modulate(rms_norm(xl, g_norm1[layer]), sh1, sc1)
        hc = modulate(rms_norm(xc, g_norm1[layer]), csh1, csc1)
        ql, kl, vl, fl = project(hl, w_in[layer], g_q[layer], g_k[layer])
        qc, kc, vc, fc = project(hc, w_in[layer], g_q[layer], g_k[layer])
        ql = axial_rope(ql, ang_row, ang_col)
        kl = axial_rope(kl, ang_row, ang_col)
        k_all = jnp.concatenate([kl, kc], axis=1)
        v_all = jnp.concatenate([vl, vc], axis=1)
        attn_l = attend(ql, k_all, v_all)
        four_l = fourier_mix(fl, w_fourier[layer], b_fourier[layer])
        xl = xl + gt1 * (jnp.concatenate([attn_l, four_l], axis=-1) @ w_out[layer])

        h2 = modulate(rms_norm(xl, g_norm2[layer]), sh2, sc2)
        xl = xl + gt2 * peer(h2, w_query[layer], sub_keys[layer], u_experts[layer], v_experts[layer])

        if layer < DEPTH - 1:
            attn_c = attend(qc, kc, vc)
            four_c = fourier_mix(fc, w_fourier[layer], b_fourier[layer])
            xc = xc + cgt1 * (jnp.concatenate([attn_c, four_c], axis=-1) @ w_out[layer])
            h2c = modulate(rms_norm(xc, g_norm2[layer]), csh2, csc2)
            xc = xc + cgt2 * peer(h2c, w_query[layer], sub_keys[layer], u_experts[layer], v_experts[layer])
    return rms_norm(xl, g_final)
```

```cpp
#include <hip/hip_runtime.h>
#include <hip/hip_bf16.h>
#include <hip/hip_cooperative_groups.h>
#include <cstdio>
#include <cstdint>
namespace cg = cooperative_groups;

typedef unsigned short bf16_t;
using bf16x8 = __attribute__((ext_vector_type(8))) short;
using s16x4  = __attribute__((ext_vector_type(4))) short;
using f32x4  = __attribute__((ext_vector_type(4))) float;
using f32x16 = __attribute__((ext_vector_type(16))) float;
using u32x4  = __attribute__((ext_vector_type(4))) unsigned;
using u32x2  = __attribute__((ext_vector_type(2))) unsigned;
typedef float f2_t __attribute__((ext_vector_type(2)));

constexpr int DM = 2048, NB = 8, SEQ = 2048, NTOK = NB * SEQ, CTX = 256, LK = SEQ + CTX;
constexpr int NMOD = 6 * DM;
constexpr int NIN = 2560;
constexpr int NT = 512;
constexpr int NEXP = 16384;
constexpr float EPS = 1e-6f;
constexpr size_t DYN_LDS = 140 * 1024;
#ifndef REPK
#define REPK -1
#endif
#define REPS(k) for (int rep_ = 0; rep_ < ((REPK) == (k) ? 2 : 1); ++rep_)

constexpr size_t al256(size_t x) { return (x + 255) / 256 * 256; }
constexpr size_t OFF_MOD   = 0;
constexpr size_t OFF_ROPE  = OFF_MOD   + al256((size_t)9 * NMOD * 4);
constexpr size_t OFF_WINT  = OFF_ROPE  + al256((size_t)64 * 32 * 2 * 4);
constexpr size_t OFF_WFIN  = OFF_WINT  + al256((size_t)NIN * DM * 2);
constexpr size_t OFF_ABT   = OFF_WFIN  + al256((size_t)DM * 1024 * 2);
constexpr size_t OFF_WOUTT = OFF_ABT   + al256((size_t)4 * 512 * 256 * 2);
constexpr size_t OFF_WQ    = OFF_WOUTT + al256((size_t)DM * DM * 2);
constexpr size_t OFF_SKBD  = OFF_WQ    + al256((size_t)DM * DM * 2);
constexpr size_t OFF_WST   = OFF_SKBD  + al256((size_t)2048 * 256 * 2);
constexpr size_t OFF_TTAB  = OFF_WST   + al256((size_t)DM * DM * 2);
constexpr size_t OFF_H     = OFF_TTAB  + al256((size_t)2048 * 4096 * 2);
constexpr size_t OFF_HC    = OFF_H     + al256((size_t)NTOK * DM * 2);
constexpr size_t OFF_Q     = OFF_HC    + al256((size_t)NB * CTX * DM * 2);
constexpr size_t OFF_K     = OFF_Q     + al256((size_t)NB * 8 * SEQ * 128 * 2);
constexpr size_t OFF_V     = OFF_K     + al256((size_t)NB * 2 * LK * 128 * 2);
constexpr size_t OFF_PQT   = OFF_V     + al256((size_t)NB * 2 * LK * 128 * 2);
constexpr size_t OFF_MIX   = OFF_PQT   + al256((size_t)NB * 4 * 256 * 4096 * 2);
constexpr size_t OFF_TOPK  = OFF_MIX   + al256((size_t)NTOK * DM * 2);
constexpr size_t OFF_UQ    = OFF_TOPK  + al256((size_t)NTOK * 256 * 4);
constexpr size_t OFF_VQ    = OFF_UQ    + al256((size_t)NEXP * DM);
constexpr size_t OFF_US    = OFF_VQ    + al256((size_t)NEXP * DM);
constexpr size_t OFF_VS    = OFF_US    + al256((size_t)NEXP * 4);
constexpr size_t OFF_F     = OFF_VS    + al256((size_t)NEXP * 4);
constexpr size_t OFF_SSQ   = OFF_F     + al256((size_t)NTOK * 1024 * 2);
constexpr size_t OFF_CVEC  = OFF_SSQ   + al256((size_t)NTOK * 16 * 4);
constexpr size_t OFF_USUM  = OFF_CVEC  + al256((size_t)8 * 2048 * 4);
constexpr size_t OFF_BAR   = OFF_USUM  + al256((size_t)NEXP * 4);
constexpr size_t WS_END    = OFF_BAR   + 16384;

struct Params {
  const float *x, *c, *ctx, *c_ctx, *w_ada, *b_ada, *g_norm1, *w_in, *g_q, *g_k, *w_fourier, *b_fourier,
              *w_out, *g_norm2, *w_query, *sub_keys, *u_exp, *v_exp, *g_final;
  float* out; char* ws;
};

__device__ __forceinline__ int otid() { int t = threadIdx.x; asm volatile("" : "+v"(t)); return t; }
template <int CTRL> __device__ __forceinline__ float dpp_f(float v) { return __int_as_float(__builtin_amdgcn_update_dpp(0, __float_as_int(v), CTRL, 0xf, 0xf, false)); }
template <int CTRL> __device__ __forceinline__ int dpp_i(int v) { return __builtin_amdgcn_update_dpp(0, v, CTRL, 0xf, 0xf, false); }
__device__ __forceinline__ float xor1_f(float v) { return dpp_f<0xB1>(v); }
__device__ __forceinline__ float xor2_f(float v) { return dpp_f<0x4E>(v); }
__device__ __forceinline__ int xor1_i(int v) { return dpp_i<0xB1>(v); }
__device__ __forceinline__ int xor2_i(int v) { return dpp_i<0x4E>(v); }
__device__ __forceinline__ float wave_sum(float v) {
  v += dpp_f<0xB1>(v); v += dpp_f<0x4E>(v); v += dpp_f<0x141>(v); v += dpp_f<0x140>(v);
  { auto rr = __builtin_amdgcn_permlane16_swap(__float_as_uint(v), __float_as_uint(v), false, false); v = __uint_as_float(rr[0]) + __uint_as_float(rr[1]); }
  { auto rr = __builtin_amdgcn_permlane32_swap(__float_as_uint(v), __float_as_uint(v), false, false); v = __uint_as_float(rr[0]) + __uint_as_float(rr[1]); }
  return v;
}
__device__ __forceinline__ int wave_sum_i(int v) {
  v += dpp_i<0xB1>(v); v += dpp_i<0x4E>(v); v += dpp_i<0x141>(v); v += dpp_i<0x140>(v);
  { auto rr = __builtin_amdgcn_permlane16_swap((unsigned)v, (unsigned)v, false, false); v = (int)rr[0] + (int)rr[1]; }
  { auto rr = __builtin_amdgcn_permlane32_swap((unsigned)v, (unsigned)v, false, false); v = (int)rr[0] + (int)rr[1]; }
  return v;
}
__device__ __forceinline__ float wave_max(float v) {
  v = fmaxf(v, dpp_f<0xB1>(v)); v = fmaxf(v, dpp_f<0x4E>(v)); v = fmaxf(v, dpp_f<0x141>(v)); v = fmaxf(v, dpp_f<0x140>(v));
  { auto rr = __builtin_amdgcn_permlane16_swap(__float_as_uint(v), __float_as_uint(v), false, false); v = fmaxf(__uint_as_float(rr[0]), __uint_as_float(rr[1])); }
  { auto rr = __builtin_amdgcn_permlane32_swap(__float_as_uint(v), __float_as_uint(v), false, false); v = fmaxf(__uint_as_float(rr[0]), __uint_as_float(rr[1])); }
  return v;
}
__device__ __forceinline__ unsigned cvtpk(float lo, float hi) {
  unsigned r; asm volatile("v_cvt_pk_bf16_f32 %0, %1, %2" : "=v"(r) : "v"(lo), "v"(hi)); return r;
}
__device__ __forceinline__ bf16_t f2bf(float f) { return (bf16_t)(cvtpk(f, 0.f) & 0xffffu); }
__device__ __forceinline__ void fmix_lo(float& acc, float w, unsigned h) { asm("v_fma_mix_f32 %0, %1, %2, %0 op_sel:[0,0,0] op_sel_hi:[0,1,0]" : "+v"(acc) : "v"(w), "v"(h)); }
__device__ __forceinline__ void fmix_hi(float& acc, float w, unsigned h) { asm("v_fma_mix_f32 %0, %1, %2, %0 op_sel:[0,1,0] op_sel_hi:[0,1,0]" : "+v"(acc) : "v"(w), "v"(h)); }
__device__ __forceinline__ unsigned and_or(unsigned x, unsigned m, unsigned o) { unsigned r; asm("v_and_or_b32 %0, %1, %2, %3" : "=v"(r) : "v"(x), "s"(m), "v"(o)); return r; }
__device__ __forceinline__ float silu(float v) { return v / (1.f + __expf(-v)); }

#define LAS __attribute__((address_space(3)))
#define XB_TMO      128
#define XB_XCNT(j)  (256  + 64 * (j))
#define XB_XSUB(j)  (1280 + 64 * (j))
#define XB_XGEN(j)  (2304 + 64 * (j))
#define XB_TOP      3328
#define XB_TOPGEN   3392
#define XCD_BAR_WORDS 3456
#define XB_SPIN_CAP (1u << 18)

__device__ __forceinline__ unsigned xb_ld(unsigned* p)              { return __hip_atomic_load(p, __ATOMIC_RELAXED, __HIP_MEMORY_SCOPE_AGENT); }
__device__ __forceinline__ unsigned xb_add(unsigned* p, unsigned v) { return __hip_atomic_fetch_add(p, v, __ATOMIC_RELAXED, __HIP_MEMORY_SCOPE_AGENT); }
__device__ __forceinline__ unsigned xb_xcc_id() { return (unsigned)__builtin_amdgcn_s_getreg((3 << 11) | 20) & 0xFu; }
#define XB_SPIN(cond, bar) do { unsigned _sp = 0; while (cond) { __builtin_amdgcn_s_sleep(1); \
    if ((++_sp & 255u) == 0u) { if (xb_ld(&(bar)[XB_TMO])) break; if (_sp > XB_SPIN_CAP) { atomicAdd(&(bar)[XB_TMO], 1u); break; } } } } while (0)

struct XcdBarrier {
    unsigned* bar; unsigned x;
    volatile LAS unsigned* st;
};

__device__ __forceinline__ XcdBarrier xcd_barrier_post(unsigned* bar, volatile LAS unsigned* st) {
    XcdBarrier b; b.bar = bar; b.x = xb_xcc_id(); b.st = st;
    if (threadIdx.x == 0) (void)xb_add(&bar[XB_XCNT(b.x)], 1u);
    return b;
}
__device__ __forceinline__ void xcd_barrier_complete(unsigned* bar, unsigned x, unsigned& nloc, unsigned& nx) {
    const unsigned G = gridDim.x * gridDim.y * gridDim.z;
    unsigned sum, cnt, mine, sp = 0u;
    for (;;) {
        sum = 0u; cnt = 0u; mine = 0u;
#pragma unroll
        for (unsigned j = 0; j < 16; ++j) { const unsigned c = xb_ld(&bar[XB_XCNT(j)]); sum += c; cnt += (c > 0u) ? 1u : 0u; mine = (j == x) ? c : mine; }
        if (sum == G) break;
        __builtin_amdgcn_s_sleep(1);
        if ((++sp & 255u) == 0u) { if (xb_ld(&bar[XB_TMO])) break; if (sp > XB_SPIN_CAP) { atomicAdd(&bar[XB_TMO], 1u); break; } }
    }
    nloc = mine > 0u ? mine : 1u; nx = cnt > 0u ? cnt : 1u;
}

__device__ __forceinline__ void xcd_barrier(const XcdBarrier& b) {
    asm volatile("s_waitcnt vmcnt(0)" ::: "memory");
    __syncthreads();
    if (threadIdx.x == 0) {
        unsigned* bar = b.bar;
        __builtin_amdgcn_s_waitcnt(0);
        unsigned nloc = b.st[0], nx = b.st[1];
        if (nloc == 0u) { xcd_barrier_complete(bar, b.x, nloc, nx); b.st[0] = nloc; b.st[1] = nx; }
        const unsigned old = xb_add(&bar[XB_XSUB(b.x)], 1u);
        const unsigned gen = old / nloc;
        if (old + 1u == (gen + 1u) * nloc) {
            __builtin_amdgcn_fence(__ATOMIC_RELEASE, "agent");
            asm volatile("s_waitcnt vmcnt(0)" ::: "memory");
            const unsigned og = xb_add(&bar[XB_TOP], 1u);
            const unsigned tg = og / nx;
            if (og + 1u == (tg + 1u) * nx) xb_add(&bar[XB_TOPGEN], 1u);
            else XB_SPIN(xb_ld(&bar[XB_TOPGEN]) == tg, bar);
            __builtin_amdgcn_fence(__ATOMIC_ACQUIRE, "agent");
            xb_add(&bar[XB_XGEN(b.x)], 1u);
            asm volatile("s_waitcnt vmcnt(0)" ::: "memory");
        } else {
            XB_SPIN(xb_ld(&bar[XB_XGEN(b.x)]) == gen, bar);
            __builtin_amdgcn_fence(__ATOMIC_ACQUIRE, "agent");
            asm volatile("s_waitcnt vmcnt(0)" ::: "memory");
        }
    }
    __syncthreads();
}


__device__ __forceinline__ void gsync(unsigned* bar, unsigned& target) {
  asm volatile("s_waitcnt vmcnt(0) lgkmcnt(0)" ::: "memory");
  __syncthreads();
  if (threadIdx.x == 0) {
    target += gridDim.x;
    __builtin_amdgcn_fence(__ATOMIC_RELEASE, "agent");
    asm volatile("s_waitcnt vmcnt(0)" ::: "memory");
    __hip_atomic_fetch_add(bar, 1u, __ATOMIC_RELAXED, __HIP_MEMORY_SCOPE_AGENT);
    while (__hip_atomic_load(bar, __ATOMIC_RELAXED, __HIP_MEMORY_SCOPE_AGENT) < target) __builtin_amdgcn_s_sleep(1);
    __builtin_amdgcn_fence(__ATOMIC_ACQUIRE, "agent");
    asm volatile("s_waitcnt vmcnt(0)" ::: "memory");
  }
  __syncthreads();
}

constexpr int STG_LD = 136;
__device__ __forceinline__ int stg_idx(int r, int c) { return r * STG_LD + c + 4 * (c >> 6); }

template <class Epi, bool TS = false>
__device__ __forceinline__ void gemm_tile2(const bf16_t* __restrict__ A, int lda, const bf16_t* __restrict__ Bt, int ldb, int K,
                                           char* shm, const Epi& epi0, const Epi& epi1) {
  const int tid = otid(), wid = tid >> 6, lane = tid & 63, wr = wid >> 1, wc = wid & 1, fr = lane & 15, fq = lane >> 4;
  f32x4 acc[4][8];
#pragma unroll
  for (int m = 0; m < 4; ++m)
#pragma unroll
    for (int n = 0; n < 8; ++n) acc[m][n] = (f32x4){0.f, 0.f, 0.f, 0.f};
  const int srow = tid >> 3, sp = tid & 7, gch = sp ^ (srow & 7);
  const bf16_t* ga = A + (size_t)srow * lda + gch * 8;
  const bf16_t* gb = Bt + (size_t)srow * ldb + gch * 8;
  LAS char* l3 = (LAS char*)shm;
  LAS char* sA = l3; LAS char* sB = l3 + 65536;
  const int loff = tid * 16;
#define GLDS(buf, k0) do { \
    _Pragma("unroll") for (int j = 0; j < 4; ++j) { \
      __builtin_amdgcn_global_load_lds((const unsigned*)(ga + (size_t)(64 * j) * lda + (k0)), (LAS unsigned*)(sA + (buf) * 32768 + j * 8192 + loff), 16, 0, 0); \
      __builtin_amdgcn_global_load_lds((const unsigned*)(gb + (size_t)(64 * j) * ldb + (k0)), (LAS unsigned*)(sB + (buf) * 32768 + j * 8192 + loff), 16, 0, 0); } } while (0)
  __syncthreads();
  GLDS(0, 0);
  asm volatile("s_waitcnt vmcnt(0)" ::: "memory");
  __syncthreads();
  const int nk = K >> 6;
  const int aoff = (wr * 64 + fr) * 128, boff = (wc * 64 + fr) * 128, sw = fr & 7;
  for (int kt = 0; kt < nk; ++kt) {
    const int buf = kt & 1;
    if (kt + 1 < nk) GLDS(buf ^ 1, (kt + 1) << 6);
    const char* cA = shm + buf * 32768 + aoff; const char* cB = shm + 65536 + buf * 32768 + boff;
#pragma unroll
    for (int ks = 0; ks < 2; ++ks) {
      const int co = ((ks * 4 + fq) ^ sw) << 4;
      bf16x8 af[4], bfr[8];
#pragma unroll
      for (int m = 0; m < 4; ++m) af[m] = *(const bf16x8*)(cA + m * 2048 + co);
#pragma unroll
      for (int n = 0; n < 8; ++n) bfr[n] = *(const bf16x8*)(cB + (n >> 2) * 16384 + (n & 3) * 2048 + co);
#pragma unroll
      for (int m = 0; m < 4; ++m)
#pragma unroll
        for (int n = 0; n < 8; ++n) acc[m][n] = __builtin_amdgcn_mfma_f32_16x16x32_bf16(af[m], bfr[n], acc[m][n], 0, 0, 0);
    }
    asm volatile("s_waitcnt vmcnt(0)" ::: "memory");
    __syncthreads();
  }
#undef GLDS
  float* stg = (float*)shm;
#pragma unroll
  for (int hb = 0; hb < 2; ++hb) {
    if (hb) __syncthreads();
    if constexpr (TS) {
#pragma unroll
      for (int m = 0; m < 4; ++m)
#pragma unroll
        for (int n = 0; n < 4; ++n)
          *(f32x4*)(stg + (wc * 64 + n * 16 + fr) * 260 + wr * 64 + m * 16 + fq * 4) = acc[m][hb * 4 + n];
    } else {
#pragma unroll
    for (int m = 0; m < 4; ++m)
#pragma unroll
      for (int n = 0; n < 4; ++n)
#pragma unroll
        for (int j = 0; j < 4; ++j)
          stg[(wr * 64 + m * 16 + fq * 4 + j) * STG_LD + wc * 68 + n * 16 + fr] = acc[m][hb * 4 + n][j];
    }
    __syncthreads();
    if (hb == 0) epi0(stg); else epi1(stg);
  }
}

__device__ __forceinline__ void ld64(const float* stg, int r, int hf, float (&v)[64]) {
  const float* p = stg + r * STG_LD + hf * 68;
#pragma unroll
  for (int j = 0; j < 16; ++j) { f32x4 t = *(const f32x4*)(p + 4 * j); v[4 * j] = t[0]; v[4 * j + 1] = t[1]; v[4 * j + 2] = t[2]; v[4 * j + 3] = t[3]; }
}
__device__ __forceinline__ void st64bf(bf16_t* dst, const float (&v)[64]) {
#pragma unroll
  for (int j = 0; j < 8; ++j) {
    u32x4 w = {cvtpk(v[8 * j], v[8 * j + 1]), cvtpk(v[8 * j + 2], v[8 * j + 3]), cvtpk(v[8 * j + 4], v[8 * j + 5]), cvtpk(v[8 * j + 6], v[8 * j + 7])};
    *(u32x4*)(dst + 8 * j) = w;
  }
}

struct EpiStoreBf16 {
  bf16_t* dst; int ld; const float* bias;
  __device__ __forceinline__ void operator()(const float* stg) const {
    const int tid_ = otid(); const int r = tid_ >> 1, hf = tid_ & 1;
    float v[64]; ld64(stg, r, hf, v);
    if (bias) {
#pragma unroll
      for (int j = 0; j < 64; ++j) v[j] += bias[hf * 64 + j];
    }
    st64bf(dst + (size_t)r * ld + hf * 64, v);
  }
};

struct EpiStoreF32 {
  float* dst; int ld;
  __device__ __forceinline__ void operator()(const float* stg) const {
    const int tid_ = otid(); const int rr = tid_ >> 5, c4 = (tid_ & 31) * 4;
    const float* sp = stg + c4 + 4 * (c4 >> 6);
#pragma unroll 4
    for (int i = 0; i < 16; ++i) { const int r = rr + 16 * i; *(f32x4*)(dst + (size_t)r * ld + c4) = *(const f32x4*)(sp + r * STG_LD); }
  }
};

struct EpiPQT {
  bf16_t* dst;
  __device__ __forceinline__ void operator()(const float* stg) const {
    const int tid_ = otid(); const int dsel = tid_ >> 5, ch = tid_ & 31;
#pragma unroll
    for (int k = 0; k < 8; ++k) {
      const int d = dsel + 16 * k;
      const f32x4 a = *(const f32x4*)(stg + d * 260 + ch * 8), c = *(const f32x4*)(stg + d * 260 + ch * 8 + 4);
      *(u32x4*)(dst + (size_t)d * 4096 + ch * 8) = (u32x4){cvtpk(a[0], a[1]), cvtpk(a[2], a[3]), cvtpk(c[0], c[1]), cvtpk(c[2], c[3])};
    }
  }
};

struct EpiInProj {
  int kind;
  int b, l0;
  int isctx;
  int head;
  int g, ab, dh;
  const float* gq; const float* gk; const float* rope;
  bf16_t *Qb, *Kb, *Vb, *PQt, *Fb; int row0, fcol;
  __device__ __forceinline__ void operator()(const float* stg) const {
    const int tid = otid();
    if (kind == 3) {
      const int dcol = tid & 127, lq = tid >> 7;
      const int d = dh * 128 + dcol;
      bf16_t* dst = PQt + ((size_t)((b * 4 + g) * 256 + d)) * 4096 + ab * 2048 + l0;
      const float* p = stg + stg_idx(0, dcol);
#pragma unroll
      for (int ch = 0; ch < 8; ++ch) {
        const int lr = (lq * 8 + ch) * 8;
        float v[8];
#pragma unroll
        for (int jj = 0; jj < 8; ++jj) v[jj] = p[(lr + jj) * STG_LD];
        u32x4 w = {cvtpk(v[0], v[1]), cvtpk(v[2], v[3]), cvtpk(v[4], v[5]), cvtpk(v[6], v[7])};
        *(u32x4*)(dst + lr) = w;
      }
      return;
    }
    const int r = tid >> 1, hf = tid & 1;
    float v[64]; ld64(stg, r, hf, v);
    if (kind == 4) { st64bf(Fb + (size_t)(row0 + r) * 1024 + fcol + hf * 64, v); return; }
    if (kind == 2) {
      st64bf(Vb + ((size_t)((b * 2 + head) * LK) + (isctx ? SEQ : l0) + r) * 128 + hf * 64, v);
      return;
    }
    float ss = 0.f;
#pragma unroll
    for (int j = 0; j < 64; ++j) ss += v[j] * v[j];
    ss += xor1_f(ss);
    const float rs = rsqrtf(ss * (1.f / 128.f) + EPS);
    const float* gg = (kind == 0 ? gq : gk) + hf * 64;
#pragma unroll
    for (int j = 0; j < 64; ++j) v[j] = v[j] * rs * gg[j];
    if (!isctx) {
      const int l = l0 + r, pos = hf == 0 ? (l >> 6) : (l & 63);
      const float* rp = rope + pos * 64;
#pragma unroll
      for (int j = 0; j < 32; ++j) {
        const float cs = rp[2 * j], sn = rp[2 * j + 1], x1 = v[j], x2 = v[j + 32];
        v[j] = x1 * cs - x2 * sn; v[j + 32] = x2 * cs + x1 * sn;
      }
    }
    if (kind == 0) st64bf(Qb + ((size_t)((b * 8 + head) * SEQ) + l0 + r) * 128 + hf * 64, v);
    else           st64bf(Kb + ((size_t)((b * 2 + head) * LK) + (isctx ? SEQ : l0) + r) * 128 + hf * 64, v);
  }
};

struct EpiOutProj {
  const float* x; const float* gt1; float* xl;
  const float* g2; const float* sc2; bf16_t* a2; float* ssq;
  __device__ __forceinline__ void operator()(const float* stg) const {
    const int tid_ = otid(); const int rr = tid_ >> 5, c4 = (tid_ & 31) * 4;
    const f32x4 gv = *(const f32x4*)(gt1 + c4);
    const f32x4 gn = *(const f32x4*)(g2 + c4), sv = *(const f32x4*)(sc2 + c4);
    const f32x4 gs = {gn[0] * (1.f + sv[0]), gn[1] * (1.f + sv[1]), gn[2] * (1.f + sv[2]), gn[3] * (1.f + sv[3])};
    const float* sp = stg + c4 + 4 * (c4 >> 6);
#pragma unroll 4
    for (int i = 0; i < 16; ++i) {
      const int r = rr + 16 * i;
      const f32x4 a = *(const f32x4*)(sp + r * STG_LD), xv = __builtin_nontemporal_load((const f32x4*)(x + (size_t)r * DM + c4));
      f32x4 ov; ov[0] = xv[0] + gv[0] * a[0]; ov[1] = xv[1] + gv[1] * a[1]; ov[2] = xv[2] + gv[2] * a[2]; ov[3] = xv[3] + gv[3] * a[3];
      *(f32x4*)(xl + (size_t)r * DM + c4) = ov;
      *(u32x2*)(a2 + (size_t)r * DM + c4) = (u32x2){cvtpk(ov[0] * gs[0], ov[1] * gs[1]), cvtpk(ov[2] * gs[2], ov[3] * gs[3])};
      float s = ov[0] * ov[0] + ov[1] * ov[1] + ov[2] * ov[2] + ov[3] * ov[3];
      s += dpp_f<0xB1>(s); s += dpp_f<0x4E>(s); s += dpp_f<0x141>(s); s += dpp_f<0x140>(s);
      { auto q = __builtin_amdgcn_permlane16_swap(__float_as_uint(s), __float_as_uint(s), false, false); s = __uint_as_float(q[0]) + __uint_as_float(q[1]); }
      if ((tid_ & 31) == 0) ssq[(size_t)r * 16] = s;
    }
  }
};

#define CE(a, b) do { float _h = fmaxf(a, b), _l = fminf(a, b); a = _h; b = _l; } while (0)
struct EpiTopk {
  unsigned* topk; int row0, seg;
  const float* ssq; const float* cvec;
  __device__ __forceinline__ void operator()(const float* stg) const {
    const int tid_ = otid(); const int r = tid_ >> 1, hf = tid_ & 1;
    const float* p = stg + r * STG_LD + hf * 68;
    float rstd;
    { const float* sq = ssq + (size_t)(row0 + r) * 16; float s = 0.f;
#pragma unroll
      for (int j4 = 0; j4 < 4; ++j4) { const f32x4 t = *(const f32x4*)(sq + 4 * j4); s += t[0]; s += t[1]; s += t[2]; s += t[3]; }
      rstd = rsqrtf(s * (1.f / DM) + EPS); }
    const float* cv = cvec + hf * 64;
    float L[16];
#define BITONIC_MERGE16(X) do { \
    _Pragma("unroll") for (int i_ = 0; i_ < 8; ++i_) CE(X[i_], X[i_ + 8]); \
    _Pragma("unroll") for (int q_ = 0; q_ < 16; q_ += 8) { _Pragma("unroll") for (int i_ = 0; i_ < 4; ++i_) CE(X[q_ + i_], X[q_ + i_ + 4]); } \
    _Pragma("unroll") for (int q_ = 0; q_ < 16; q_ += 4) { _Pragma("unroll") for (int i_ = 0; i_ < 2; ++i_) CE(X[q_ + i_], X[q_ + i_ + 2]); } \
    _Pragma("unroll") for (int q_ = 0; q_ < 16; q_ += 2) CE(X[q_], X[q_ + 1]); } while (0)
#pragma unroll
    for (int ch = 0; ch < 4; ++ch) {
      float C[16];
#pragma unroll
      for (int j4 = 0; j4 < 4; ++j4) { const f32x4 t = *(const f32x4*)(p + ch * 16 + 4 * j4); const f32x4 cb = *(const f32x4*)(cv + ch * 16 + 4 * j4);
#pragma unroll
        for (int e = 0; e < 4; ++e) C[4 * j4 + e] = __uint_as_float((__float_as_uint(fmaf(t[e], rstd, cb[e])) & ~127u) | (unsigned)(hf * 64 + ch * 16 + j4 * 4 + e)); }
#pragma unroll
      for (int k = 2; k <= 16; k <<= 1)
#pragma unroll
        for (int j = k >> 1; j > 0; j >>= 1)
#pragma unroll
          for (int i = 0; i < 16; ++i) { const int l = i ^ j; if (l > i) { if ((i & k) == 0) CE(C[i], C[l]); else CE(C[l], C[i]); } }
      if (ch == 0) {
#pragma unroll
        for (int i = 0; i < 16; ++i) L[i] = C[i];
      } else {
#pragma unroll
        for (int i = 0; i < 16; ++i) L[i] = fmaxf(L[i], C[15 - i]);
        BITONIC_MERGE16(L);
      }
    }
    float M[16];
#pragma unroll
    for (int i = 0; i < 16; ++i) M[i] = fmaxf(L[i], xor1_f(L[15 - i]));
#pragma unroll
    for (int i = 0; i < 8; ++i) CE(M[i], M[i + 8]);
#pragma unroll
    for (int q = 0; q < 16; q += 8)
#pragma unroll
      for (int i = 0; i < 4; ++i) CE(M[q + i], M[q + i + 4]);
#pragma unroll
    for (int q = 0; q < 16; q += 4)
#pragma unroll
      for (int i = 0; i < 2; ++i) CE(M[q + i], M[q + i + 2]);
#pragma unroll
    for (int q = 0; q < 16; q += 2) CE(M[q], M[q + 1]);
    unsigned* dst = topk + ((size_t)(row0 + r) * 16 + seg) * 16 + hf * 8;
    u32x4 w0, w1;
    if (hf == 0) { w0 = (u32x4){__float_as_uint(M[0]), __float_as_uint(M[1]), __float_as_uint(M[2]), __float_as_uint(M[3])};
                   w1 = (u32x4){__float_as_uint(M[4]), __float_as_uint(M[5]), __float_as_uint(M[6]), __float_as_uint(M[7])}; }
    else         { w0 = (u32x4){__float_as_uint(M[8]), __float_as_uint(M[9]), __float_as_uint(M[10]), __float_as_uint(M[11])};
                   w1 = (u32x4){__float_as_uint(M[12]), __float_as_uint(M[13]), __float_as_uint(M[14]), __float_as_uint(M[15])}; }
    *(u32x4*)dst = w0; *(u32x4*)(dst + 4) = w1;
  }
};

namespace attn {
constexpr int D = 128, NW = 8, QBLK = 32, KVBLK = 64;
constexpr float SCALE = 0.088388347648318440f;
constexpr float THR = 8.f;
constexpr int LDQ = 128, LDK = 128, LDO = DM;
constexpr size_t SHM_V = KVBLK * D * 2, SHM_K = KVBLK * D * 2;
#define KSWZ(row, colB) ((row) * 256 + ((colB) ^ (((row) & 7) << 4)))
#define SBAR() __builtin_amdgcn_sched_barrier(0)
__device__ __forceinline__ int crow(int r, int hi) { return (r & 3) + 8 * (r >> 2) + 4 * hi; }
__device__ __forceinline__ void partialSM(f32x16& p0, f32x16& p1, float& m_reg, float& mn, float& alpha) {
  constexpr float C = SCALE * 1.4426950408889634f;
  float pmax = p0[0];
#pragma unroll
  for (int r = 1; r < 16; ++r) pmax = fmaxf(pmax, p0[r]);
#pragma unroll
  for (int r = 0; r < 16; ++r) pmax = fmaxf(pmax, p1[r]);
  { auto rr = __builtin_amdgcn_permlane32_swap(__float_as_uint(pmax), __float_as_uint(pmax), false, false);
    pmax = fmaxf(__uint_as_float(rr[0]), __uint_as_float(rr[1])); }
  if (__builtin_expect(__all(pmax - m_reg <= THR / SCALE), 1)) { mn = m_reg; alpha = 1.f; }
  else { mn = fmaxf(m_reg, pmax); alpha = __builtin_amdgcn_exp2f((m_reg - mn) * C); m_reg = mn; }
  float mnC = -mn * C;
#pragma unroll
  for (int r = 0; r < 16; ++r) p0[r] = fmaf(p0[r], C, mnC);
#pragma unroll
  for (int r = 0; r < 16; ++r) p1[r] = fmaf(p1[r], C, mnC);
#pragma unroll
  for (int r = 0; r < 16; ++r) p0[r] = __builtin_amdgcn_exp2f(p0[r]);
}
__device__ __forceinline__ void finishSM(f32x16& p0, f32x16& p1, float alpha, float& l_reg, bf16x8& pa0, bf16x8& pa1, bf16x8& pa2, bf16x8& pa3) {
#pragma unroll
  for (int r = 0; r < 16; ++r) p1[r] = __builtin_amdgcn_exp2f(p1[r]);
  float ps = 0;
#pragma unroll
  for (int r = 0; r < 16; ++r) ps += p0[r];
#pragma unroll
  for (int r = 0; r < 16; ++r) ps += p1[r];
  { auto rr = __builtin_amdgcn_permlane32_swap(__float_as_uint(ps), __float_as_uint(ps), false, false);
    ps = __uint_as_float(rr[0]) + __uint_as_float(rr[1]); }
  l_reg = l_reg * alpha + ps;
#define PK4(P, BASE, OUT) do { unsigned a0 = cvtpk(P[BASE + 0], P[BASE + 1]), a1 = cvtpk(P[BASE + 2], P[BASE + 3]);   \
    unsigned b0 = cvtpk(P[BASE + 4], P[BASE + 5]), b1 = cvtpk(P[BASE + 6], P[BASE + 7]);                              \
    auto r0 = __builtin_amdgcn_permlane32_swap(a0, b0, false, false); auto r1 = __builtin_amdgcn_permlane32_swap(a1, b1, false, false); \
    u32x4 w = {r0[0], r1[0], r0[1], r1[1]}; OUT = *reinterpret_cast<bf16x8*>(&w); } while (0)
  PK4(p0, 0, pa0); PK4(p0, 8, pa1); PK4(p1, 0, pa2); PK4(p1, 8, pa3);
#undef PK4
}
__device__ __forceinline__ void qkt(f32x16& p0, f32x16& p1, const char* Ks, const bf16x8* qr, int r32, int hi) {
  p0 = f32x16{}; p1 = f32x16{};
#pragma unroll
  for (int d0 = 0; d0 < 8; ++d0) { int cb = (d0 * 16 + hi * 8) * 2;
    bf16x8 b0 = *reinterpret_cast<const bf16x8*>(Ks + KSWZ(r32, cb));
    bf16x8 b1 = *reinterpret_cast<const bf16x8*>(Ks + KSWZ(32 + r32, cb));
    p0 = __builtin_amdgcn_mfma_f32_32x32x16_bf16(b0, qr[d0], p0, 0, 0, 0);
    p1 = __builtin_amdgcn_mfma_f32_32x32x16_bf16(b1, qr[d0], p1, 0, 0, 0); }
}
__device__ __forceinline__ int v_st(int k, int c) { const int kk = (k & ~0xC) | ((k & 4) << 1) | ((k & 8) >> 1); return ((kk >> 3) * 4 + (c >> 5)) * 512 + ((kk & 7) * 32 + (c & 31)) * 2; }
__device__ __forceinline__ int v_rd_base(int lane) { return ((lane & 3) << 3) | (((lane >> 2) & 3) << 6) | (((lane >> 4) & 1) << 5) | (((lane >> 5) & 1) << 8); }
constexpr int v_rd_off(int d0, int ks, int half) { return d0 * 512 + ks * 4096 + half * 2048; }
template <int OFF> __device__ __forceinline__ s16x4 tr_read(int vb) {
  s16x4 r; asm volatile("ds_read_b64_tr_b16 %0, %1 offset:%2" : "=&v"(r) : "v"(vb), "i"(OFF) : "memory"); return r;
}
template <int D0> __device__ __forceinline__ void pv_one(f32x16& od, int vb, bf16x8 pa0, bf16x8 pa1, bf16x8 pa2, bf16x8 pa3) {
  const s16x4 l0 = tr_read<v_rd_off(D0, 0, 0)>(vb), h0 = tr_read<v_rd_off(D0, 0, 1)>(vb), l1 = tr_read<v_rd_off(D0, 1, 0)>(vb), h1 = tr_read<v_rd_off(D0, 1, 1)>(vb);
  const s16x4 l2 = tr_read<v_rd_off(D0, 2, 0)>(vb), h2 = tr_read<v_rd_off(D0, 2, 1)>(vb), l3 = tr_read<v_rd_off(D0, 3, 0)>(vb), h3 = tr_read<v_rd_off(D0, 3, 1)>(vb);
  asm volatile("s_waitcnt lgkmcnt(0)" ::: "memory"); SBAR();
#define PK(L, H) (bf16x8){L[0], L[1], L[2], L[3], H[0], H[1], H[2], H[3]}
  od = __builtin_amdgcn_mfma_f32_32x32x16_bf16(pa0, PK(l0, h0), od, 0, 0, 0);
  od = __builtin_amdgcn_mfma_f32_32x32x16_bf16(pa1, PK(l1, h1), od, 0, 0, 0);
  od = __builtin_amdgcn_mfma_f32_32x32x16_bf16(pa2, PK(l2, h2), od, 0, 0, 0);
  od = __builtin_amdgcn_mfma_f32_32x32x16_bf16(pa3, PK(l3, h3), od, 0, 0, 0);
#undef PK
}
__device__ __forceinline__ void pv_d0(f32x16* o, int vb, bf16x8 pa0, bf16x8 pa1, bf16x8 pa2, bf16x8 pa3) {
  pv_one<0>(o[0], vb, pa0, pa1, pa2, pa3); pv_one<1>(o[1], vb, pa0, pa1, pa2, pa3); pv_one<2>(o[2], vb, pa0, pa1, pa2, pa3); pv_one<3>(o[3], vb, pa0, pa1, pa2, pa3);
}
__device__ __forceinline__ void body(const bf16_t* __restrict__ Qb, const bf16_t* __restrict__ Kh, const bf16_t* __restrict__ Vh,
                                     bf16_t* __restrict__ Ob, int seq, char* lds) {
  const int tid = otid(), wid = tid >> 6, lane = tid & 63, r32 = lane & 31, hi = lane >> 5;
  char* V_lds = lds; char* K_lds = lds + 2 * SHM_V;
  float* ws = (float*)(lds + 2 * SHM_V + 2 * SHM_K) + wid * 64; float* li_l = ws; float* al_l = ws + 32;
  float m_reg = -1e30f, l_reg = 0; f32x16 o[4] = {}; bf16x8 qr[8];
  const bf16_t* Qw = Qb + (long)(wid * QBLK + r32) * LDQ + hi * 8;
#pragma unroll
  for (int d0 = 0; d0 < 8; ++d0) qr[d0] = *(const bf16x8*)(Qw + d0 * 16);
  const int sr = tid >> 4, sc = (tid & 15) * 8, vst0 = v_st(sr, sc), vst1 = v_st(32 + sr, sc);
  const int vb0 = (int)(uintptr_t)V_lds + v_rd_base(lane);
  struct { bf16x8 vs0, vs1, ks0, ks1; } sr_[1];
#define SLOAD(i, k0) do { sr_[i].vs0 = *(const bf16x8*)(&Vh[(long)((k0) + sr) * LDK + sc]); sr_[i].vs1 = *(const bf16x8*)(&Vh[(long)((k0) + 32 + sr) * LDK + sc]); \
    sr_[i].ks0 = *(const bf16x8*)(&Kh[(long)((k0) + sr) * LDK + sc]); sr_[i].ks1 = *(const bf16x8*)(&Kh[(long)((k0) + 32 + sr) * LDK + sc]); } while (0)
#define SWRITE(b, i) do { *(bf16x8*)(V_lds + (b) * SHM_V + vst0) = sr_[i].vs0;          \
    *(bf16x8*)(V_lds + (b) * SHM_V + vst1) = sr_[i].vs1; int kc = sc * 2;               \
    *(bf16x8*)(K_lds + (b) * SHM_K + KSWZ(sr, kc)) = sr_[i].ks0;                       \
    *(bf16x8*)(K_lds + (b) * SHM_K + KSWZ(32 + sr, kc)) = sr_[i].ks1; } while (0)
#define SWAIT() asm volatile("s_waitcnt vmcnt(0)" ::: "memory")
#define RESC(a) do { if (__any((a) < 1.f)) { if (hi == 0) al_l[r32] = (a); asm volatile("s_waitcnt lgkmcnt(0)" ::: "memory"); \
    for (int d = 0; d < 4; ++d) for (int r = 0; r < 16; ++r) o[d][r] *= al_l[crow(r, hi)]; } } while (0)
  f32x16 pA0, pA1, pB0, pB1; float mnA, mnB, alA, alB; bf16x8 pa0, pa1, pa2, pa3; const int NTL = seq / KVBLK;
  constexpr int SE = 0, SO = 0;
  SLOAD(SE, 0); asm volatile("s_waitcnt vmcnt(0)" ::: "memory"); SWRITE(0, SE); __syncthreads();
  qkt(pA0, pA1, K_lds, qr, r32, hi); partialSM(pA0, pA1, m_reg, mnA, alA);
  SLOAD(SO, KVBLK);
  SWAIT(); SWRITE(1, SO); __syncthreads();
  for (int j = 1; j + 1 < NTL; j += 2) {
    SBAR(); qkt(pB0, pB1, K_lds + SHM_K, qr, r32, hi);
    finishSM(pA0, pA1, alA, l_reg, pa0, pa1, pa2, pa3); SBAR();
    SLOAD(SO, (j + 1) * KVBLK); SBAR();
    pv_d0(o, vb0, pa0, pa1, pa2, pa3); partialSM(pB0, pB1, m_reg, mnB, alB);
    __syncthreads(); SWAIT(); SWRITE(0, SE);
    RESC(alB); __syncthreads();
    SBAR(); qkt(pA0, pA1, K_lds, qr, r32, hi);
    finishSM(pB0, pB1, alB, l_reg, pa0, pa1, pa2, pa3); SBAR();
    SLOAD(SE, (j + 2) * KVBLK); SBAR();
    pv_d0(o, vb0 + (int)SHM_V, pa0, pa1, pa2, pa3); partialSM(pA0, pA1, m_reg, mnA, alA);
    __syncthreads(); SWAIT(); SWRITE(1, SO);
    RESC(alA); __syncthreads();
  }
  SBAR(); qkt(pB0, pB1, K_lds + SHM_K, qr, r32, hi);
  finishSM(pA0, pA1, alA, l_reg, pa0, pa1, pa2, pa3); SBAR();
  pv_d0(o, vb0, pa0, pa1, pa2, pa3); partialSM(pB0, pB1, m_reg, mnB, alB);
  __syncthreads(); RESC(alB);
  finishSM(pB0, pB1, alB, l_reg, pa0, pa1, pa2, pa3); SBAR();
  pv_d0(o, vb0 + (int)SHM_V, pa0, pa1, pa2, pa3);
  if (hi == 0) li_l[r32] = l_reg; asm volatile("s_waitcnt lgkmcnt(0)" ::: "memory");
  float rli[16];
#pragma unroll
  for (int r = 0; r < 16; ++r) rli[r] = __builtin_amdgcn_rcpf(li_l[crow(r, hi)]);
  bf16_t* Ow = Ob + (long)(wid * QBLK) * LDO;
#pragma unroll
  for (int r = 0; r < 16; ++r) { int orow = crow(r, hi);
#pragma unroll
    for (int d0 = 0; d0 < 4; ++d0) Ow[(long)orow * LDO + d0 * 32 + r32] = f2bf(o[d0][r] * rli[r]); }
#undef SLOAD
#undef SWRITE
#undef SWAIT
#undef RESC
  __syncthreads();
}
}

__device__ __forceinline__ void job_mod(const Params& p, int it, char* shm) {
  const int tid = otid(), w = tid >> 6, lane = tid & 63, rg = lane >> 4, cl = lane & 15;
  float* sc = (float*)shm;
  float* red = (float*)(shm + 73728);
  __syncthreads();
  for (int i = tid; i < 9 * 2048; i += NT) { int r = i >> 11, k = i & 2047; float v = r < 8 ? p.c[r * DM + k] : p.c_ctx[k]; sc[i] = silu(v); }
  __syncthreads();
  float a[9][4];
#pragma unroll
  for (int r = 0; r < 9; ++r)
#pragma unroll
    for (int q = 0; q < 4; ++q) a[r][q] = 0.f;
  const float* wp = p.w_ada + (size_t)(w * 256 + rg) * NMOD + it * 64 + cl * 4;
  const float* sp = sc + w * 256 + rg;
#pragma unroll 8
  for (int kk = 0; kk < 64; ++kk) {
    const f32x4 wv = __builtin_nontemporal_load((const f32x4*)(wp + (size_t)(kk * 4) * NMOD));
#pragma unroll
    for (int r = 0; r < 9; ++r) { const float s = sp[r * 2048 + kk * 4];
#pragma unroll
      for (int q = 0; q < 4; ++q) a[r][q] += s * wv[q]; }
  }
#pragma unroll
  for (int r = 0; r < 9; ++r)
#pragma unroll
    for (int q = 0; q < 4; ++q) { float v = a[r][q]; v += __shfl_xor(v, 16); v += __shfl_xor(v, 32); a[r][q] = v; }
  if (rg == 0) {
#pragma unroll
    for (int r = 0; r < 9; ++r) *(f32x4*)(red + (w * 9 + r) * 64 + cl * 4) = (f32x4){a[r][0], a[r][1], a[r][2], a[r][3]};
  }
  __syncthreads();
  float* mod = (float*)(p.ws + OFF_MOD);
  for (int o = tid; o < 576; o += NT) { const int r = o >> 6, cc = o & 63; float s = p.b_ada[it * 64 + cc];
#pragma unroll
    for (int ww = 0; ww < 8; ++ww) s += red[(ww * 9 + r) * 64 + cc];
    mod[r * NMOD + it * 64 + cc] = s; }
}
__device__ __forceinline__ void job_transpose(const float* src, int ld, int coff, bf16_t* dst, int ldd, int tr, int tc, char* shm) {
  float* s = (float*)shm;
  const int tid = otid();
  __syncthreads();
  for (int i = tid; i < 4096; i += NT) { int r = i >> 6, c = i & 63; s[r * 65 + c] = src[(size_t)(tr * 64 + r) * ld + coff + tc * 64 + c]; }
  __syncthreads();
  for (int i = tid; i < 4096; i += NT) { int c = i >> 6, r = i & 63; dst[(size_t)(tc * 64 + c) * ldd + tr * 64 + r] = f2bf(s[r * 65 + c]); }
}
__device__ __forceinline__ unsigned quant_pack8(const float* v, float inv, int off, int& qsum) {
  unsigned pk = 0;
#pragma unroll
  for (int b = 0; b < 4; ++b) {
    int lo = (int)floorf(v[b] * inv), hi = (int)floorf(v[4 + b] * inv);
    lo = max(-8, min(7, lo)); hi = max(-8, min(7, hi)); qsum += lo + hi; lo += off; hi += off;
    pk |= ((unsigned)lo & 15u) << (8 * b); pk |= ((unsigned)hi & 15u) << (8 * b + 4);
  }
  return pk;
}
__device__ __forceinline__ unsigned quant_pack8_fp4(const float* v, float inv) {
  unsigned pk = 0;
#pragma unroll
  for (int b = 0; b < 8; ++b) {
    const float y = v[b] * inv, a = fabsf(y);
    unsigned c = (a > 0.25f) + (a > 0.75f) + (a > 1.25f) + (a > 1.75f) + (a > 2.5f) + (a > 3.5f) + (a > 5.0f);
    c |= y < 0.f ? 8u : 0u;
    pk |= c << (b < 4 ? 8 * b : 8 * (b - 4) + 4);
  }
  return pk;
}
__device__ __forceinline__ void job_quant_rows2(const float* src, unsigned char* dstq, float* dsts, int* dsum, int row, int lane, int off) {
  const float* r = src + (size_t)row * DM;
  float v[2][32];
#pragma unroll
  for (int k = 0; k < 2; ++k)
#pragma unroll
    for (int i = 0; i < 8; ++i) { f32x4 t = __builtin_nontemporal_load((const f32x4*)(r + k * DM + i * 256 + lane * 4)); v[k][4 * i] = t[0]; v[k][4 * i + 1] = t[1]; v[k][4 * i + 2] = t[2]; v[k][4 * i + 3] = t[3]; }
  float ss[2] = {0.f, 0.f};
#pragma unroll
  for (int k = 0; k < 2; ++k)
#pragma unroll
    for (int j = 0; j < 32; ++j) ss[k] += v[k][j] * v[k][j];
  ss[0] = wave_sum(ss[0]); ss[1] = wave_sum(ss[1]);
#pragma unroll
  for (int k = 0; k < 2; ++k) {
    const float rms = sqrtf(ss[k] * (1.f / DM));
    const float step = rms > 0.f ? (off == 8 ? 0.48f : 0.3352f) * rms : 1.f, inv = 1.f / step;
    int qs = 0;
    u32x4 w;
    if (off == 8) w = (u32x4){quant_pack8_fp4(&v[k][0], inv), quant_pack8_fp4(&v[k][8], inv), quant_pack8_fp4(&v[k][16], inv), quant_pack8_fp4(&v[k][24], inv)};
    else w = (u32x4){quant_pack8(&v[k][0], inv, off, qs), quant_pack8(&v[k][8], inv, off, qs), quant_pack8(&v[k][16], inv, off, qs), quant_pack8(&v[k][24], inv, off, qs)};
    *(u32x4*)(dstq + (size_t)(row + k) * 1024 + lane * 16) = w;
    qs = wave_sum_i(qs);
    if (lane == 0) { dsts[row + k] = step; if (dsum) dsum[row + k] = qs; }
  }
}

constexpr int J0 = 0, J1 = J0 + 192, J2 = J1 + 1280, J3 = J2 + 1024, J4 = J3 + 0, J5 = J4 + 1024, J6 = J5 + 128, J7 = J6 + 256,
              J8 = J7 + 512, J9 = J8 + 1, JEND = J9;

__device__ void phase0(const Params& p, char* shm) {
  const int tid = otid(), wid = tid >> 6, lane = tid & 63;
  for (int it = blockIdx.x; it < JEND; it += gridDim.x) {
    if (it < J1) job_mod(p, it - J0, shm);
    else if (it < J2) { int t = it - J1; job_transpose(p.w_in, 2560, 0, (bf16_t*)(p.ws + OFF_WINT), DM, t / 40, t % 40, shm); }
    else if (it < J3) { int t = it - J2; job_transpose(p.w_out, DM, 0, (bf16_t*)(p.ws + OFF_WOUTT), DM, t / 32, t % 32, shm); }
    else if (it < J4) {
      int base = (it - J3) * 4096 + tid * 8; int j = base >> 10, c = base & 1023;
      const float* s = p.w_in + (size_t)j * 2560 + 1536 + c; f32x4 a = *(const f32x4*)s, b = *(const f32x4*)(s + 4);
      *(u32x4*)((bf16_t*)(p.ws + OFF_WFIN) + base) = (u32x4){cvtpk(a[0], a[1]), cvtpk(a[2], a[3]), cvtpk(b[0], b[1]), cvtpk(b[2], b[3])};
    } else if (it < J5) {
      int base = (it - J4) * 4096 + tid * 8; const float* s = p.w_query + base; f32x4 a = *(const f32x4*)s, b = *(const f32x4*)(s + 4);
      *(u32x4*)((bf16_t*)(p.ws + OFF_WQ) + base) = (u32x4){cvtpk(a[0], a[1]), cvtpk(a[2], a[3]), cvtpk(b[0], b[1]), cvtpk(b[2], b[3])};
    } else if (it < J6) {
      int base = (it - J5) * 4096 + tid * 8; int row = base >> 8, col = base & 255; int hp = row >> 7;
      u32x4 w = {0u, 0u, 0u, 0u};
      if ((col >> 7) == (hp & 1)) { const float* s = p.sub_keys + (size_t)row * 128 + (col & 127); f32x4 a = *(const f32x4*)s, b = *(const f32x4*)(s + 4);
        w = (u32x4){cvtpk(a[0], a[1]), cvtpk(a[2], a[3]), cvtpk(b[0], b[1]), cvtpk(b[2], b[3])}; }
      *(u32x4*)((bf16_t*)(p.ws + OFF_SKBD) + base) = w;
    } else if (it < J7) {
      const int t = it - J6; const int g = t >> 6, ab = (t >> 5) & 1, c = (t & 31) * 8 + wid;
      float* tb = (float*)shm;
      __syncthreads();
      if (tid < 256) { float ang = (float)tid * (1.f / 128.f); tb[tid] = ab ? sinpif(ang) : cospif(ang); }
      __syncthreads();
      const float* wf = p.w_fourier + (size_t)g * 65536 + lane * 4;
      f32x4 a4 = {0.f, 0.f, 0.f, 0.f};
#pragma unroll 16
      for (int m = 0; m < 256; ++m) { const f32x4 wv = *(const f32x4*)(wf + m * 256); const float tv = tb[(m * c) & 255];
        a4[0] += tv * wv[0]; a4[1] += tv * wv[1]; a4[2] += tv * wv[2]; a4[3] += tv * wv[3]; }
      bf16_t* o = (bf16_t*)(p.ws + OFF_ABT) + ((size_t)(g * 512 + ab * 256 + lane * 4)) * 256 + c;
#pragma unroll
      for (int q = 0; q < 4; ++q) o[q * 256] = f2bf(a4[q] * 0.0013810679320049757f);
    } else if (it < J8) {
      int base = (it - J7) * 16384 + tid * 8;
      for (int rep = 0; rep < 4; ++rep, base += 4096) {
        int k = base >> 12, cl = base & 4095; unsigned w[4];
#pragma unroll
        for (int e = 0; e < 4; ++e) { float v2[2];
#pragma unroll
          for (int q = 0; q < 2; ++q) { int col = cl + e * 2 + q; int l = col & 2047; float ang = (float)((k * l) & 2047) * (1.f / 1024.f); v2[q] = (col >> 11) ? -sinpif(ang) : cospif(ang); }
          w[e] = cvtpk(v2[0], v2[1]); }
        *(u32x4*)((bf16_t*)(p.ws + OFF_TTAB) + base) = (u32x4){w[0], w[1], w[2], w[3]};
      }
    } else if (it < J9) {
      float* rt = (float*)(p.ws + OFF_ROPE);
      for (int i = tid; i < 2048; i += NT) { int pos = i >> 5, j = i & 31; float inv = powf(10000.f, -(float)j / 32.f); float ang = (float)pos * inv; rt[2 * i] = cosf(ang); rt[2 * i + 1] = sinf(ang); }
    }
  }
}
__device__ __forceinline__ void quant_item(const Params& p, int q) {
  const int tid = otid(), wid = tid >> 6, lane = tid & 63;
  const int row = (q & 1023) * 16 + wid * 2;
  if (q < 1024) job_quant_rows2(p.u_exp, (unsigned char*)(p.ws + OFF_UQ), (float*)(p.ws + OFF_US), (int*)(p.ws + OFF_USUM), row, lane, 0);
  else          job_quant_rows2(p.v_exp, (unsigned char*)(p.ws + OFF_VQ), (float*)(p.ws + OFF_VS), nullptr, row, lane, 8);
}

__device__ __forceinline__ void norm_mod_row2(const float* xr, const float* g, const float* sh, const float* sc, bf16_t* dst, int lane) {
  float v[2][32];
#pragma unroll
  for (int k = 0; k < 2; ++k)
#pragma unroll
    for (int i = 0; i < 8; ++i) { f32x4 t = __builtin_nontemporal_load((const f32x4*)(xr + k * DM + i * 256 + lane * 4)); v[k][4 * i] = t[0]; v[k][4 * i + 1] = t[1]; v[k][4 * i + 2] = t[2]; v[k][4 * i + 3] = t[3]; }
  float ss0 = 0.f, ss1 = 0.f;
#pragma unroll
  for (int j = 0; j < 32; ++j) { ss0 += v[0][j] * v[0][j]; ss1 += v[1][j] * v[1][j]; }
  ss0 = wave_sum(ss0); ss1 = wave_sum(ss1);
  const float rs0 = rsqrtf(ss0 * (1.f / DM) + EPS), rs1 = rsqrtf(ss1 * (1.f / DM) + EPS);
#pragma unroll
  for (int i = 0; i < 8; ++i) {
    const int c = i * 256 + lane * 4;
    const f32x4 gv = *(const f32x4*)(g + c), sv = *(const f32x4*)(sh + c), cv = *(const f32x4*)(sc + c);
    float m[4];
#pragma unroll
    for (int q = 0; q < 4; ++q) m[q] = gv[q] * (1.f + cv[q]);
    *(u32x2*)(dst + c) = (u32x2){cvtpk(v[0][4 * i] * rs0 * m[0] + sv[0], v[0][4 * i + 1] * rs0 * m[1] + sv[1]), cvtpk(v[0][4 * i + 2] * rs0 * m[2] + sv[2], v[0][4 * i + 3] * rs0 * m[3] + sv[3])};
    *(u32x2*)(dst + DM + c) = (u32x2){cvtpk(v[1][4 * i] * rs1 * m[0] + sv[0], v[1][4 * i + 1] * rs1 * m[1] + sv[1]), cvtpk(v[1][4 * i + 2] * rs1 * m[2] + sv[2], v[1][4 * i + 3] * rs1 * m[3] + sv[3])};
  }
}

__device__ __forceinline__ void peer_wave8(const Params& p, int tbase, int tstride, int ntok, char* wlds, int lane) {
  unsigned* keys = (unsigned*)wlds; int* eidxU = (int*)(wlds + 1024); float* gateU = (float*)(wlds + 1536);
  float* cand = (float*)(wlds + 2048); float* tokf = (float*)(wlds + 2304);
  unsigned short* eidxS = (unsigned short*)(wlds + 2560); float* gw = (float*)(wlds + 4608); int* red = (int*)(wlds + 8704);
  const float* mod = (const float*)(p.ws + OFF_MOD);
  unsigned* H2Q = (unsigned*)(p.ws + OFF_F);
  const unsigned char* Uq = (const unsigned char*)(p.ws + OFF_UQ); const float* Us = (const float*)(p.ws + OFF_US);
  const unsigned char* Vq = (const unsigned char*)(p.ws + OFF_VQ); const float* Vs = (const float*)(p.ws + OFF_VS);
  int ci = 0, cj = 0;
  { int cnt = 0;
#pragma unroll
    for (int i = 0; i < 16; ++i) { const int nj = 16 / (i + 1); if (lane >= cnt) { ci = i; cj = lane - cnt; } cnt += nj; } }
  asm volatile("" : "+v"(ci), "+v"(cj));
  const bool valid = lane < 50;
  for (int ti = 0; ti < ntok; ++ti) {
    const int t = tbase + ti * tstride, b = t >> 11;
    const unsigned* tk = (const unsigned*)(p.ws + OFF_TOPK) + (size_t)t * 256;
#pragma unroll
    for (int i = 0; i < 4; ++i) keys[i * 64 + lane] = tk[i * 64 + lane];
    __builtin_amdgcn_s_waitcnt(0xc07f);
    for (int h = 0; h < 8; ++h) {
      unsigned k1 = keys[(2 * h) * 16 + ci], k2 = keys[(2 * h + 1) * 16 + cj];
      float sv = __uint_as_float(k1 & ~127u) + __uint_as_float(k2 & ~127u);
      sv = valid ? __uint_as_float((__float_as_uint(sv) & ~63u) | (unsigned)(63 - lane)) : -3.0e38f;
      cand[lane] = sv;
      __builtin_amdgcn_s_waitcnt(0xc07f);
      int rank = 0;
#pragma unroll
      for (int o4 = 0; o4 < 13; ++o4) { f32x4 ov = *(const f32x4*)(cand + o4 * 4);
#pragma unroll
        for (int q = 0; q < 4; ++q) rank += (ov[q] > sv) ? 1 : 0; }
      const float mx = wave_max(sv);
      const bool sel = valid && rank < 16;
      float e = sel ? __expf(sv - mx) : 0.f;
      float se = wave_sum(e);
      if (sel) { eidxU[h * 16 + rank] = (int)((k1 & 127u) * 128u + (k2 & 127u)); gateU[h * 16 + rank] = e / se; }
    }
    __builtin_amdgcn_s_waitcnt(0xc07f);
    {
      const int e0 = eidxU[lane], e1 = eidxU[64 + lane]; const float g0 = gateU[lane], g1 = gateU[64 + lane];
      const int b0 = e0 >> 11, b1 = e1 >> 11;
      int pos0 = 0, pos1 = 0, base = 0;
#pragma unroll
      for (int bk = 0; bk < 8; ++bk) {
        const unsigned long long m0 = __ballot(b0 == bk), m1 = __ballot(b1 == bk);
        const int c0 = __popcll(m0), c1 = __popcll(m1);
        const int r0 = __builtin_amdgcn_mbcnt_hi((unsigned)(m0 >> 32), __builtin_amdgcn_mbcnt_lo((unsigned)m0, 0u));
        const int r1 = __builtin_amdgcn_mbcnt_hi((unsigned)(m1 >> 32), __builtin_amdgcn_mbcnt_lo((unsigned)m1, 0u));
        if (b0 == bk) pos0 = base + r0;
        if (b1 == bk) pos1 = base + c0 + r1;
        base += c0 + c1;
      }
      eidxS[ti * 128 + pos0] = (unsigned short)e0; gw[ti * 128 + pos0] = g0;
      eidxS[ti * 128 + pos1] = (unsigned short)e1; gw[ti * 128 + pos1] = g1;
    }
    const float* xrow = p.out + (size_t)t * DM;
    float xv[32];
#pragma unroll
    for (int i = 0; i < 8; ++i) { f32x4 tt = __builtin_nontemporal_load((const f32x4*)(xrow + i * 256 + lane * 4)); xv[4 * i] = tt[0]; xv[4 * i + 1] = tt[1]; xv[4 * i + 2] = tt[2]; xv[4 * i + 3] = tt[3]; }
    float ss = 0.f;
#pragma unroll
    for (int j = 0; j < 32; ++j) ss += xv[j] * xv[j];
    ss = wave_sum(ss);
    const float rs = rsqrtf(ss * (1.f / DM) + EPS);
    const float* sh2 = mod + b * NMOD + 3 * DM; const float* sc2 = mod + b * NMOD + 4 * DM;
    float hss = 0.f;
#pragma unroll
    for (int i = 0; i < 8; ++i) { const int c = i * 256 + lane * 4;
      const f32x4 g2 = *(const f32x4*)(p.g_norm2 + c), s2 = *(const f32x4*)(sc2 + c), h2 = *(const f32x4*)(sh2 + c);
#pragma unroll
      for (int q = 0; q < 4; ++q) { float hh = xv[4 * i + q] * rs * g2[q] * (1.f + s2[q]) + h2[q]; xv[4 * i + q] = hh; hss += hh * hh; } }
    hss = wave_sum(hss);
    const float hrms = sqrtf(hss * (1.f / DM));
    const float hsc = hrms > 0.f ? 0.3352f * hrms : 1.f, hinv = 1.f / hsc;
    int hsum = 0;
    const u32x4 hq4 = {quant_pack8(&xv[0], hinv, 0, hsum), quant_pack8(&xv[8], hinv, 0, hsum), quant_pack8(&xv[16], hinv, 0, hsum), quant_pack8(&xv[24], hinv, 0, hsum)};
    hsum = wave_sum_i(hsum);
    *(u32x4*)(H2Q + ((size_t)t * 64 + lane) * 4) = hq4;
    if (lane == 0) { tokf[ti * 2] = hsc; tokf[ti * 2 + 1] = (float)hsum; }
  }
  asm volatile("s_waitcnt vmcnt(0) lgkmcnt(0)" ::: "memory");
  u32x4 rA[16], rB[16]; u32x4 qA0, qA1, qB0, qB1;
  const int* Usum = (const int*)(p.ws + OFF_USUM);
#define ULOAD(R, Q0, Q1, S) do { const int j_ = (S) / ntok, ti_ = (S) - j_ * ntok; const int t_ = tbase + ti_ * tstride; \
    Q0 = *(const u32x4*)(H2Q + ((size_t)t_ * 64 + lane) * 4); \
    _Pragma("unroll") for (int i = 0; i < 16; ++i) { const int e_ = eidxS[ti_ * 128 + j_ * 16 + i]; R[i] = *(const u32x4*)(Uq + (size_t)e_ * 1024 + lane * 16); } } while (0)
#define UCOMP(R, Q0, Q1, S) do { const int j_ = (S) / ntok, ti_ = (S) - j_ * ntok; \
    _Pragma("unroll") for (int i = 0; i < 16; ++i) { int d_ = 0; \
      _Pragma("unroll") for (int q = 0; q < 4; ++q) d_ = __builtin_amdgcn_sdot8((int)Q0[q], (int)R[i][q], d_, false); \
      red[i * 64 + lane] = d_; } \
    __builtin_amdgcn_s_waitcnt(0xc07f); \
    const int ee_ = lane >> 2, sub_ = lane & 3; const int* rp_ = red + ee_ * 64 + sub_ * 16; int dd_ = 0; \
    _Pragma("unroll") for (int q = 0; q < 4; ++q) { const u32x4 qq_ = *(const u32x4*)(rp_ + 4 * q); dd_ += (int)qq_[0] + (int)qq_[1] + (int)qq_[2] + (int)qq_[3]; } \
    dd_ += xor1_i(dd_); dd_ += xor2_i(dd_); \
    const int k_ = ti_ * 128 + j_ * 16 + ee_, e2_ = eidxS[k_]; \
    const float pre_ = ((float)dd_ + 0.5f * (float)Usum[e2_] + 0.5f * tokf[ti_ * 2 + 1] + 512.f) * tokf[ti_ * 2] * Us[e2_]; \
    const float a_ = 0.5f * pre_ * (1.f + erff(pre_ * 0.70710678118654752f)); \
    const float w_ = gw[k_] * a_ * Vs[e2_]; \
    __builtin_amdgcn_s_waitcnt(0xc07f); \
    if (sub_ == 0) gw[k_] = w_; } while (0)
  {
    const int S = 8 * ntok;
    ULOAD(rA, qA0, qA1, 0);
    for (int s = 0; s < S; s += 2) {
      ULOAD(rB, qB0, qB1, s + 1); SBAR();
      UCOMP(rA, qA0, qA1, s); SBAR();
      if (s + 2 < S) ULOAD(rA, qA0, qA1, s + 2);
      SBAR();
      UCOMP(rB, qB0, qB1, s + 1); SBAR();
    }
  }
#undef ULOAD
#undef UCOMP
  __builtin_amdgcn_s_waitcnt(0xc07f);
  int laneC = lane; asm volatile("" : "+v"(laneC));
#define VLOAD(R, TI, KB) do { _Pragma("unroll") for (int i = 0; i < 4; ++i) { const int e_ = eidxS[(TI) * 128 + (KB) * 4 + i]; R[i] = *(const u32x4*)(Vq + (size_t)e_ * 1024 + laneC * 16); } } while (0)
#define VCOMP(ACC, R, TI, KB) do { \
    _Pragma("unroll") for (int i = 0; i < 4; ++i) { const float w_ = gw[(TI) * 128 + (KB) * 4 + i]; const f2_t w2_ = {w_, w_}; \
      _Pragma("unroll") for (int q = 0; q < 4; ++q) { const unsigned x_ = R[i][q]; \
        ACC[4 * q + 0] = __builtin_elementwise_fma(__builtin_amdgcn_cvt_scalef32_pk_f32_fp4(x_, 1.0f, 0), w2_, ACC[4 * q + 0]); \
        ACC[4 * q + 1] = __builtin_elementwise_fma(__builtin_amdgcn_cvt_scalef32_pk_f32_fp4(x_, 1.0f, 1), w2_, ACC[4 * q + 1]); \
        ACC[4 * q + 2] = __builtin_elementwise_fma(__builtin_amdgcn_cvt_scalef32_pk_f32_fp4(x_, 1.0f, 2), w2_, ACC[4 * q + 2]); \
        ACC[4 * q + 3] = __builtin_elementwise_fma(__builtin_amdgcn_cvt_scalef32_pk_f32_fp4(x_, 1.0f, 3), w2_, ACC[4 * q + 3]); } } } while (0)
#define VFINAL(ACC, TI) do { const int t_ = tbase + (TI) * tstride, b_ = t_ >> 11; \
    float* xrow_ = p.out + (size_t)t_ * DM; const float* gt2_ = mod + b_ * NMOD + 5 * DM; float ss2_ = 0.f; \
    _Pragma("unroll") for (int i = 0; i < 8; ++i) { const int c = i * 256 + laneC * 4; const f32x4 g4 = *(const f32x4*)(gt2_ + c), x4 = __builtin_nontemporal_load((const f32x4*)(xrow_ + c)); \
      _Pragma("unroll") for (int q = 0; q < 4; ++q) { float y = x4[q] + g4[q] * ACC[4 * (i >> 1) + q][i & 1]; ACC[4 * (i >> 1) + q][i & 1] = y; ss2_ += y * y; } } \
    ss2_ = wave_sum(ss2_); const float rs2_ = rsqrtf(ss2_ * (1.f / DM) + EPS); \
    _Pragma("unroll") for (int i = 0; i < 8; ++i) { const int c = i * 256 + laneC * 4; const f32x4 gf = *(const f32x4*)(p.g_final + c); f32x4 ov; \
      ov[0] = ACC[4 * (i >> 1)][i & 1] * rs2_ * gf[0]; ov[1] = ACC[4 * (i >> 1) + 1][i & 1] * rs2_ * gf[1]; ov[2] = ACC[4 * (i >> 1) + 2][i & 1] * rs2_ * gf[2]; ov[3] = ACC[4 * (i >> 1) + 3][i & 1] * rs2_ * gf[3]; \
      __builtin_nontemporal_store(ov, (f32x4*)(xrow_ + c)); } } while (0)
  for (int pg = 0; pg < ntok; pg += 2) {
    const int tiA = pg, tiB = pg + 1 < ntok ? pg + 1 : pg;
    f2_t accA[16], accB[16];
#pragma unroll
    for (int j = 0; j < 16; ++j) { accA[j] = (f2_t){0.f, 0.f}; accB[j] = (f2_t){0.f, 0.f}; }
    VLOAD(rA, tiA, 0);
    for (int j = 0; j < 32; ++j) {
      VLOAD(rB, tiB, j); SBAR();
      VCOMP(accA, rA, tiA, j); SBAR();
      if (j + 1 < 32) VLOAD(rA, tiA, j + 1);
      SBAR();
      VCOMP(accB, rB, tiB, j); SBAR();
    }
    VFINAL(accA, tiA);
    if (pg + 1 < ntok) VFINAL(accB, tiB);
  }
#undef VFINAL
#undef VLOAD
#undef VCOMP
}

__global__ void __launch_bounds__(NT) mega(Params p) {
  cg::grid_group grid = cg::this_grid();
  extern __shared__ __attribute__((aligned(16))) char shm[];
  const int G = gridDim.x, bid = blockIdx.x;
  char* ws = p.ws;
  const float* mod = (const float*)(ws + OFF_MOD);
  bf16_t* WinT = (bf16_t*)(ws + OFF_WINT);
  bf16_t* Hb = (bf16_t*)(ws + OFF_H); bf16_t* HCb = (bf16_t*)(ws + OFF_HC);
  unsigned* gbar = (unsigned*)(ws + OFF_BAR); unsigned gtarget = 0; (void)gtarget;
  volatile LAS unsigned* xst = (volatile LAS unsigned*)(LAS char*)(shm + DYN_LDS - 16);
  if (threadIdx.x == 0) { xst[0] = 0u; xst[1] = 0u; }
  __syncthreads();
  const XcdBarrier xb = xcd_barrier_post(gbar, xst);

  REPS(0) phase0(p, shm);
  if (p.ws == nullptr) grid.sync();
  xcd_barrier(xb);

  REPS(1) for (int it = bid; it < 64 + 1152; it += G) {
    if (false) {
    } else if (it < 64) {
      const int t2 = it, tm = t2 >> 3, tn = t2 & 7;
      bf16_t* o = (bf16_t*)(ws + OFF_WST) + (size_t)(tm * 256) * DM + tn * 256;
      EpiStoreBf16 e0{o, DM, nullptr}, e1{o + 128, DM, nullptr};
      gemm_tile2((const bf16_t*)(ws + OFF_SKBD) + (size_t)(tm * 256) * 256, 256,
                 (const bf16_t*)(ws + OFF_WQ) + (size_t)(tn * 256) * DM + tm * 256, DM, 256, shm, e0, e1);
    } else {
      const int tid = otid(), wid = tid >> 6, lane = tid & 63;
      const int row = (it - 64) * 16 + wid * 2;
      if (row < NTOK) { const int b = row >> 11; norm_mod_row2(p.x + (size_t)row * DM, p.g_norm1, mod + b * NMOD, mod + b * NMOD + DM, Hb + (size_t)row * DM, lane); }
      else { const int rc = row - NTOK; norm_mod_row2(p.ctx + (size_t)rc * DM, p.g_norm1, mod + 8 * NMOD, mod + 8 * NMOD + DM, HCb + (size_t)rc * DM, lane); }
    }
  }
  xcd_barrier(xb);

  REPS(2) for (int it = bid; it < 64 * 10 + 16 + 256; it += G) {
    if (it >= 64 * 10 + 16) {
      const int tid = otid(), wid = tid >> 6, lane = tid & 63, n = (it - (64 * 10 + 16)) * 8 + wid;
      const bf16_t* wr_ = (const bf16_t*)(ws + OFF_WST) + (size_t)n * DM + lane * 8;
      float wv[32];
#pragma unroll
      for (int i = 0; i < 4; ++i) { const u32x4 t = *(const u32x4*)(wr_ + i * 512);
#pragma unroll
        for (int q = 0; q < 4; ++q) { wv[i * 8 + 2 * q] = __uint_as_float(t[q] << 16); wv[i * 8 + 2 * q + 1] = __uint_as_float(t[q] & 0xffff0000u); } }
      for (int b = 0; b < 8; ++b) { const float* sh = mod + b * NMOD + 3 * DM + lane * 8; float s = 0.f;
#pragma unroll
        for (int i = 0; i < 4; ++i) { const f32x4 a = *(const f32x4*)(sh + i * 512), c = *(const f32x4*)(sh + i * 512 + 4);
          s += a[0] * wv[i * 8] + a[1] * wv[i * 8 + 1] + a[2] * wv[i * 8 + 2] + a[3] * wv[i * 8 + 3] + c[0] * wv[i * 8 + 4] + c[1] * wv[i * 8 + 5] + c[2] * wv[i * 8 + 6] + c[3] * wv[i * 8 + 7]; }
        s = wave_sum(s);
        if (lane == 0) ((float*)(ws + OFF_CVEC))[b * 2048 + n] = s; }
      continue;
    }
    EpiInProj e[2];
    const bool lat = it < 64 * 10;
    const int tn = lat ? it / 64 : (it - 64 * 10) & 1, tm = lat ? it % 64 : (it - 64 * 10) >> 1;
#pragma unroll
    for (int hb = 0; hb < 2; ++hb) {
      EpiInProj& ep = e[hb];
      ep = EpiInProj{};
      ep.gq = p.g_q; ep.gk = p.g_k; ep.rope = (const float*)(ws + OFF_ROPE);
      ep.Qb = (bf16_t*)(ws + OFF_Q); ep.Kb = (bf16_t*)(ws + OFF_K); ep.Vb = (bf16_t*)(ws + OFF_V); ep.PQt = (bf16_t*)(ws + OFF_PQT); ep.Fb = (bf16_t*)(ws + OFF_F);
      if (lat) {
        const int t1 = tn * 2 + hb;
        ep.b = tm >> 3; ep.l0 = (tm & 7) * 256; ep.isctx = 0; ep.row0 = tm * 256;
        if (t1 < 8) { ep.kind = 0; ep.head = t1; }
        else if (t1 < 10) { ep.kind = 1; ep.head = t1 - 8; }
        else if (t1 < 12) { ep.kind = 2; ep.head = t1 - 10; }
        else { ep.kind = 4; ep.fcol = (t1 - 12) * 128; }
      } else { ep.b = tm; ep.l0 = 0; ep.isctx = 1; ep.kind = tn == 0 ? 1 : 2; ep.head = hb; }
    }
    if (lat) gemm_tile2(Hb + (size_t)(tm * 256) * DM, DM, WinT + (size_t)(tn * 256) * DM, DM, DM, shm, e[0], e[1]);
    else     gemm_tile2(HCb + (size_t)(tm * 256) * DM, DM, WinT + (size_t)(1024 + tn * 256) * DM, DM, DM, shm, e[0], e[1]);
  }
  if (G == 256) {
    if (bid < 144) { for (int k = 0; k < 3; ++k) quant_item(p, bid * 3 + k); }
    else { for (int q = 432 + (bid - 144); q < 2048; q += 112) quant_item(p, q); }
  } else { for (int q = bid; q < 2048; q += G) quant_item(p, q); }
  xcd_barrier(xb);

  for (int it = bid; it < 512; it += G) {
    const int g = it >> 7, ab = (it >> 6) & 1, tm = it & 63;
    bf16_t* o = (bf16_t*)(ws + OFF_PQT) + ((size_t)(((tm >> 3) * 4 + g) * 256)) * 4096 + ab * 2048 + (tm & 7) * 256;
    EpiPQT e0{o}, e1{o + (size_t)128 * 4096};
    gemm_tile2<EpiPQT, true>((const bf16_t*)(ws + OFF_F) + (size_t)(tm * 256) * 1024 + g * 256, 1024,
               (const bf16_t*)(ws + OFF_ABT) + (size_t)(g * 512 + ab * 256) * 256, 256, 256, shm, e0, e1);
  }
  xcd_barrier(xb);

  {
    bf16_t* mix = (bf16_t*)(ws + OFF_MIX);
    const int xcd = bid & 7, jj = bid >> 3;
    REPS(3) for (int it = bid; it < 512; it += G) {
      int b, h, qb;
      if (G == 256) { const int rnd = it >> 8, pair = rnd * 8 + xcd; b = pair >> 1; h = (pair & 1) * 4 + (jj >> 3); qb = jj & 7; }
      else { b = it >> 6; h = (it >> 3) & 7; qb = it & 7; }
      const int kvh = h >> 2;
      attn::body((const bf16_t*)(ws + OFF_Q) + ((size_t)((b * 8 + h) * SEQ) + qb * 256) * 128,
                 (const bf16_t*)(ws + OFF_K) + (size_t)((b * 2 + kvh) * LK) * 128,
                 (const bf16_t*)(ws + OFF_V) + (size_t)((b * 2 + kvh) * LK) * 128,
                 mix + (size_t)(b * SEQ + qb * 256) * DM + h * 128, LK, shm);
    }
    float* UW = (float*)(ws + OFF_H);
    REPS(4) for (int it = bid; it < 256; it += G) {
      const int bg = it >> 3, uw = (it >> 2) & 1, tm = it & 3;
      float* o = UW + ((size_t)(uw * 32 + bg) * 1024 + tm * 256) * 256;
      EpiStoreF32 e0{o, 256}, e1{o + 128, 256};
      gemm_tile2((const bf16_t*)(ws + OFF_TTAB) + (size_t)(tm * 256) * 4096 + uw * 2048, 4096,
                 (const bf16_t*)(ws + OFF_PQT) + (size_t)(bg * 256) * 4096 + uw * 2048, 4096, 2048, shm, e0, e1);
    }
    xcd_barrier(xb);
    for (int it = bid; it < 4096 + 1024; it += G) {
      const int tid = otid(), wid = tid >> 6, lane = tid & 63;
      if (it < 4096) {
        const int row = it * 8 + wid, bg = row >> 10, k = row & 1023, b = bg >> 2, g = bg & 3, d = lane * 4;
        const f32x4 u = __builtin_nontemporal_load((const f32x4*)(UW + ((size_t)bg * 1024 + k) * 256 + d)), w = __builtin_nontemporal_load((const f32x4*)(UW + ((size_t)(32 + bg) * 1024 + k) * 256 + d));
        const f32x4 bs = *(const f32x4*)(p.b_fourier + g * 256 + d);
        bf16_t* o = mix + (size_t)(b * SEQ + k) * DM + 1024 + g * 256 + d;
        *(u32x2*)o = (u32x2){cvtpk(u[0] + w[0] + bs[0], u[1] + w[1] + bs[1]), cvtpk(u[2] + w[2] + bs[2], u[3] + w[3] + bs[3])};
        if (k > 0) { bf16_t* o2 = mix + (size_t)(b * SEQ + 2048 - k) * DM + 1024 + g * 256 + d;
          *(u32x2*)o2 = (u32x2){cvtpk(u[0] - w[0] + bs[0], u[1] - w[1] + bs[1]), cvtpk(u[2] - w[2] + bs[2], u[3] - w[3] + bs[3])}; }
      } else {
        const int q = (it - 4096) * 8 + wid, bg = q >> 8, d = q & 255, b = bg >> 2, g = bg & 3;
        const bf16_t* pr = (const bf16_t*)(ws + OFF_PQT) + (size_t)(bg * 256 + d) * 4096 + lane * 8;
        float s = 0.f;
#pragma unroll
        for (int i = 0; i < 4; ++i) { const u32x4 t = *(const u32x4*)(pr + i * 512);
#pragma unroll
          for (int e = 0; e < 4; ++e) s += __uint_as_float(t[e] << 16) - __uint_as_float(t[e] & 0xffff0000u); }
        s = wave_sum(s);
        if (lane == 0) mix[(size_t)(b * SEQ + 1024) * DM + 1024 + g * 256 + d] = f2bf(s + p.b_fourier[g * 256 + d]);
      }
    }
  }
  xcd_barrier(xb);

  REPS(5) for (int it = bid; it < 512; it += G) {
    const int tn = it >> 6, tm = it & 63, b = tm >> 3;
    const size_t o = (size_t)(tm * 256) * DM + tn * 256;
    const float* mb = mod + b * NMOD;
    EpiOutProj e0{p.x + o, mb + 2 * DM + tn * 256, p.out + o, p.g_norm2 + tn * 256, mb + 4 * DM + tn * 256, Hb + o, (float*)(ws + OFF_SSQ) + (size_t)(tm * 256) * 16 + tn * 2};
    EpiOutProj e1{p.x + o + 128, mb + 2 * DM + tn * 256 + 128, p.out + o + 128, p.g_norm2 + tn * 256 + 128, mb + 4 * DM + tn * 256 + 128, Hb + o + 128, (float*)(ws + OFF_SSQ) + (size_t)(tm * 256) * 16 + tn * 2 + 1};
    gemm_tile2((const bf16_t*)(ws + OFF_MIX) + (size_t)(tm * 256) * DM, DM, (const bf16_t*)(ws + OFF_WOUTT) + (size_t)(tn * 256) * DM, DM, DM, shm, e0, e1);
  }
  xcd_barrier(xb);

  REPS(7) for (int it = bid; it < 512; it += G) {
    const int tn = it >> 6, tm = it & 63;
    const float* cvb = (const float*)(ws + OFF_CVEC) + (tm >> 3) * 2048 + tn * 256;
    EpiTopk e0{(unsigned*)(ws + OFF_TOPK), tm * 256, tn * 2, (const float*)(ws + OFF_SSQ), cvb}, e1{(unsigned*)(ws + OFF_TOPK), tm * 256, tn * 2 + 1, (const float*)(ws + OFF_SSQ), cvb + 128};
    gemm_tile2(Hb + (size_t)(tm * 256) * DM, DM, (const bf16_t*)(ws + OFF_WST) + (size_t)(tn * 256) * DM, DM, DM, shm, e0, e1);
  }
  xcd_barrier(xb);

  if ((REPK) == 9) { for (int i_ = 0; i_ < 10; ++i_) xcd_barrier(xb); }
  {
    const int tid = otid(), wid = tid >> 6, lane = tid & 63;
    char* wl = shm + wid * 12800;
    for (int it0 = bid; it0 < 2048; it0 += 8 * G) {
      const int rem = (2048 - it0 + G - 1) / G, ntok = rem < 8 ? rem : 8;
      peer_wave8(p, it0 * 8 + wid, G * 8, ntok, wl, lane);
    }
  }
}

extern "C" void kernel_launch(void* const* d_in, const int* in_sizes, int n_in,
                              void* d_out, int out_size, void* d_ws, size_t ws_size,
                              hipStream_t stream) {
  static int grid_blocks = 0;
  if (!grid_blocks) {
    int dev = 0, cus = 0, per_cu = 0;
    (void)hipGetDevice(&dev);
    (void)hipDeviceGetAttribute(&cus, hipDeviceAttributeMultiprocessorCount, dev);
    (void)hipFuncSetAttribute((const void*)mega, hipFuncAttributeMaxDynamicSharedMemorySize, (int)DYN_LDS);
    (void)hipOccupancyMaxActiveBlocksPerMultiprocessor(&per_cu, mega, NT, DYN_LDS);
    if (per_cu < 1) per_cu = 1;
    grid_blocks = cus * per_cu;
    if (ws_size < WS_END) fprintf(stderr, "workspace too small: %zu < %zu\n", ws_size, (size_t)WS_END);
  }
  Params p{};
  const float** pp = (const float**)&p;
  for (int i = 0; i < 19; ++i) pp[i] = (const float*)d_in[i];
  p.out = (float*)d_out; p.ws = (char*)d_ws;
  (void)hipMemsetAsync((char*)d_ws + OFF_BAR, 0, 16384, stream);
  void* args[] = {&p};
  hipError_t e = hipLaunchCooperativeKernel((void*)mega, dim3(grid_blocks), dim3(NT), args, DYN_LDS, stream);
  if (e != hipSuccess) fprintf(stderr, "cooperative launch failed: %s (grid %d)\n", hipGetErrorString(e), grid_blocks);
}
```

```cpp
#include <hip/hip_runtime.h>
#include <hip/hip_bf16.h>
#include <hip/hip_cooperative_groups.h>
#include <cstdio>
#include <cstdint>
namespace cg = cooperative_groups;

typedef unsigned short bf16_t;
using bf16x8 = __attribute__((ext_vector_type(8))) short;
using s16x4  = __attribute__((ext_vector_type(4))) short;
using f32x4  = __attribute__((ext_vector_type(4))) float;
using f32x16 = __attribute__((ext_vector_type(16))) float;
using u32x4  = __attribute__((ext_vector_type(4))) unsigned;
using u32x2  = __attribute__((ext_vector_type(2))) unsigned;
typedef float f2_t __attribute__((ext_vector_type(2)));

constexpr int DM = 2048, NB = 8, SEQ = 2048, NTOK = NB * SEQ, CTX = 256, LK = SEQ + CTX;
constexpr int NMOD = 6 * DM;
constexpr int NIN = 2560;
constexpr int NT = 512;
constexpr int NEXP = 16384;
constexpr float EPS = 1e-6f;
constexpr size_t DYN_LDS = 140 * 1024;
#ifndef REPK
#define REPK -1
#endif
#define REPS(k) for (int rep_ = 0; rep_ < ((REPK) == (k) ? 2 : 1); ++rep_)

constexpr size_t al256(size_t x) { return (x + 255) / 256 * 256; }
constexpr size_t OFF_MOD   = 0;
constexpr size_t OFF_ROPE  = OFF_MOD   + al256((size_t)9 * NMOD * 4);
constexpr size_t OFF_WINT  = OFF_ROPE  + al256((size_t)64 * 32 * 2 * 4);
constexpr size_t OFF_WFIN  = OFF_WINT  + al256((size_t)NIN * DM * 2);
constexpr size_t OFF_ABT   = OFF_WFIN  + al256((size_t)DM * 1024 * 2);
constexpr size_t OFF_WOUTT = OFF_ABT   + al256((size_t)4 * 512 * 256 * 2);
constexpr size_t OFF_WQ    = OFF_WOUTT + al256((size_t)DM * DM * 2);
constexpr size_t OFF_SKBD  = OFF_WQ    + al256((size_t)DM * DM * 2);
constexpr size_t OFF_WST   = OFF_SKBD  + al256((size_t)2048 * 256 * 2);
constexpr size_t OFF_TTAB  = OFF_WST   + al256((size_t)DM * DM * 2);
constexpr size_t OFF_H     = OFF_TTAB  + al256((size_t)2048 * 4096 * 2);
constexpr size_t OFF_HC    = OFF_H     + al256((size_t)NTOK * DM * 2);
constexpr size_t OFF_Q     = OFF_HC    + al256((size_t)NB * CTX * DM * 2);
constexpr size_t OFF_K     = OFF_Q     + al256((size_t)NB * 8 * SEQ * 128 * 2);
constexpr size_t OFF_V     = OFF_K     + al256((size_t)NB * 2 * LK * 128 * 2);
constexpr size_t OFF_PQT   = OFF_V     + al256((size_t)NB * 2 * LK * 128 * 2);
constexpr size_t OFF_MIX   = OFF_PQT   + al256((size_t)NB * 4 * 256 * 4096 * 2);
constexpr size_t OFF_TOPK  = OFF_MIX   + al256((size_t)NTOK * DM * 2);
constexpr size_t OFF_UQ    = OFF_TOPK  + al256((size_t)NTOK * 256 * 4);
constexpr size_t OFF_VQ    = OFF_UQ    + al256((size_t)NEXP * DM);
constexpr size_t OFF_US    = OFF_VQ    + al256((size_t)NEXP * DM);
constexpr size_t OFF_VS    = OFF_US    + al256((size_t)NEXP * 4);
constexpr size_t OFF_F     = OFF_VS    + al256((size_t)NEXP * 4);
constexpr size_t OFF_SSQ   = OFF_F     + al256((size_t)NTOK * 1024 * 2);
constexpr size_t OFF_CVEC  = OFF_SSQ   + al256((size_t)NTOK * 16 * 4);
constexpr size_t OFF_USUM  = OFF_CVEC  + al256((size_t)8 * 2048 * 4);
constexpr size_t OFF_BAR   = OFF_USUM  + al256((size_t)NEXP * 4);
constexpr size_t WS_END    = OFF_BAR   + 16384;

struct Params {
  const float *x, *c, *ctx, *c_ctx, *w_ada, *b_ada, *g_norm1, *w_in, *g_q, *g_k, *w_fourier, *b_fourier,
              *w_out, *g_norm2, *w_query, *sub_keys, *u_exp, *v_exp, *g_final;
  float* out; char* ws;
};

__device__ __forceinline__ int otid() { int t = threadIdx.x; asm volatile("" : "+v"(t)); return t; }
template <int CTRL> __device__ __forceinline__ float dpp_f(float v) { return __int_as_float(__builtin_amdgcn_update_dpp(0, __float_as_int(v), CTRL, 0xf, 0xf, false)); }
template <int CTRL> __device__ __forceinline__ int dpp_i(int v) { return __builtin_amdgcn_update_dpp(0, v, CTRL, 0xf, 0xf, false); }
__device__ __forceinline__ float xor1_f(float v) { return dpp_f<0xB1>(v); }
__device__ __forceinline__ float xor2_f(float v) { return dpp_f<0x4E>(v); }
__device__ __forceinline__ int xor1_i(int v) { return dpp_i<0xB1>(v); }
__device__ __forceinline__ int xor2_i(int v) { return dpp_i<0x4E>(v); }
__device__ __forceinline__ float wave_sum(float v) {
  v += dpp_f<0xB1>(v); v += dpp_f<0x4E>(v); v += dpp_f<0x141>(v); v += dpp_f<0x140>(v);
  { auto rr = __builtin_amdgcn_permlane16_swap(__float_as_uint(v), __float_as_uint(v), false, false); v = __uint_as_float(rr[0]) + __uint_as_float(rr[1]); }
  { auto rr = __builtin_amdgcn_permlane32_swap(__float_as_uint(v), __float_as_uint(v), false, false); v = __uint_as_float(rr[0]) + __uint_as_float(rr[1]); }
  return v;
}
__device__ __forceinline__ int wave_sum_i(int v) {
  v += dpp_i<0xB1>(v); v += dpp_i<0x4E>(v); v += dpp_i<0x141>(v); v += dpp_i<0x140>(v);
  { auto rr = __builtin_amdgcn_permlane16_swap((unsigned)v, (unsigned)v, false, false); v = (int)rr[0] + (int)rr[1]; }
  { auto rr = __builtin_amdgcn_permlane32_swap((unsigned)v, (unsigned)v, false, false); v = (int)rr[0] + (int)rr[1]; }
  return v;
}
__device__ __forceinline__ float wave_max(float v) {
  v = fmaxf(v, dpp_f<0xB1>(v)); v = fmaxf(v, dpp_f<0x4E>(v)); v = fmaxf(v, dpp_f<0x141>(v)); v = fmaxf(v, dpp_f<0x140>(v));
  { auto rr = __builtin_amdgcn_permlane16_swap(__float_as_uint(v), __float_as_uint(v), false, false); v = fmaxf(__uint_as_float(rr[0]), __uint_as_float(rr[1])); }
  { auto rr = __builtin_amdgcn_permlane32_swap(__float_as_uint(v), __float_as_uint(v), false, false); v = fmaxf(__uint_as_float(rr[0]), __uint_as_float(rr[1])); }
  return v;
}
__device__ __forceinline__ unsigned cvtpk(float lo, float hi) {
  unsigned r; asm volatile("v_cvt_pk_bf16_f32 %0, %1, %2" : "=v"(r) : "v"(lo), "v"(hi)); return r;
}
__device__ __forceinline__ bf16_t f2bf(float f) { return (bf16_t)(cvtpk(f, 0.f) & 0xffffu); }
__device__ __forceinline__ void fmix_lo(float& acc, float w, unsigned h) { asm("v_fma_mix_f32 %0, %1, %2, %0 op_sel:[0,0,0] op_sel_hi:[0,1,0]" : "+v"(acc) : "v"(w), "v"(h)); }
__device__ __forceinline__ void fmix_hi(float& acc, float w, unsigned h) { asm("v_fma_mix_f32 %0, %1, %2, %0 op_sel:[0,1,0] op_sel_hi:[0,1,0]" : "+v"(acc) : "v"(w), "v"(h)); }
__device__ __forceinline__ unsigned and_or(unsigned x, unsigned m, unsigned o) { unsigned r; asm("v_and_or_b32 %0, %1, %2, %3" : "=v"(r) : "v"(x), "s"(m), "v"(o)); return r; }
__device__ __forceinline__ float silu(float v) { return v / (1.f + __expf(-v)); }

#define LAS __attribute__((address_space(3)))
#define XB_TMO      128
#define XB_XCNT(j)  (256  + 64 * (j))
#define XB_XSUB(j)  (1280 + 64 * (j))
#define XB_XGEN(j)  (2304 + 64 * (j))
#define XB_TOP      3328
#define XB_TOPGEN   3392
#define XCD_BAR_WORDS 3456
#define XB_SPIN_CAP (1u << 18)

__device__ __forceinline__ unsigned xb_ld(unsigned* p)              { return __hip_atomic_load(p, __ATOMIC_RELAXED, __HIP_MEMORY_SCOPE_AGENT); }
__device__ __forceinline__ unsigned xb_add(unsigned* p, unsigned v) { return __hip_atomic_fetch_add(p, v, __ATOMIC_RELAXED, __HIP_MEMORY_SCOPE_AGENT); }
__device__ __forceinline__ unsigned xb_xcc_id() { return (unsigned)__builtin_amdgcn_s_getreg((3 << 11) | 20) & 0xFu; }
#define XB_SPIN(cond, bar) do { unsigned _sp = 0; while (cond) { __builtin_amdgcn_s_sleep(1); \
    if ((++_sp & 255u) == 0u) { if (xb_ld(&(bar)[XB_TMO])) break; if (_sp > XB_SPIN_CAP) { atomicAdd(&(bar)[XB_TMO], 1u); break; } } } } while (0)

struct XcdBarrier {
    unsigned* bar; unsigned x;
    volatile LAS unsigned* st;
};

__device__ __forceinline__ XcdBarrier xcd_barrier_post(unsigned* bar, volatile LAS unsigned* st) {
    XcdBarrier b; b.bar = bar; b.x = xb_xcc_id(); b.st = st;
    if (threadIdx.x == 0) (void)xb_add(&bar[XB_XCNT(b.x)], 1u);
    return b;
}
__device__ __forceinline__ void xcd_barrier_complete(unsigned* bar, unsigned x, unsigned& nloc, unsigned& nx) {
    const unsigned G = gridDim.x * gridDim.y * gridDim.z;
    unsigned sum, cnt, mine, sp = 0u;
    for (;;) {
        sum = 0u; cnt = 0u; mine = 0u;
#pragma unroll
        for (unsigned j = 0; j < 16; ++j) { const unsigned c = xb_ld(&bar[XB_XCNT(j)]); sum += c; cnt += (c > 0u) ? 1u : 0u; mine = (j == x) ? c : mine; }
        if (sum == G) break;
        __builtin_amdgcn_s_sleep(1);
        if ((++sp & 255u) == 0u) { if (xb_ld(&bar[XB_TMO])) break; if (sp > XB_SPIN_CAP) { atomicAdd(&bar[XB_TMO], 1u); break; } }
    }
    nloc = mine > 0u ? mine : 1u; nx = cnt > 0u ? cnt : 1u;
}

__device__ __forceinline__ void xcd_barrier(const XcdBarrier& b) {
    asm volatile("s_waitcnt vmcnt(0)" ::: "memory");
    __syncthreads();
    if (threadIdx.x == 0) {
        unsigned* bar = b.bar;
        __builtin_amdgcn_s_waitcnt(0);
        unsigned nloc = b.st[0], nx = b.st[1];
        if (nloc == 0u) { xcd_barrier_complete(bar, b.x, nloc, nx); b.st[0] = nloc; b.st[1] = nx; }
        const unsigned old = xb_add(&bar[XB_XSUB(b.x)], 1u);
        const unsigned gen = old / nloc;
        if (old + 1u == (gen + 1u) * nloc) {
            __builtin_amdgcn_fence(__ATOMIC_RELEASE, "agent");
            asm volatile("s_waitcnt vmcnt(0)" ::: "memory");
            const unsigned og = xb_add(&bar[XB_TOP], 1u);
            const unsigned tg = og / nx;
            if (og + 1u == (tg + 1u) * nx) xb_add(&bar[XB_TOPGEN], 1u);
            else XB_SPIN(xb_ld(&bar[XB_TOPGEN]) == tg, bar);
            __builtin_amdgcn_fence(__ATOMIC_ACQUIRE, "agent");
            xb_add(&bar[XB_XGEN(b.x)], 1u);
            asm volatile("s_waitcnt vmcnt(0)" ::: "memory");
        } else {
            XB_SPIN(xb_ld(&bar[XB_XGEN(b.x)]) == gen, bar);
            __builtin_amdgcn_fence(__ATOMIC_ACQUIRE, "agent");
            asm volatile("s_waitcnt vmcnt(0)" ::: "memory");
        }
    }
    __syncthreads();
}


__device__ __forceinline__ void gsync(unsigned* bar, unsigned& target) {
  asm volatile("s_waitcnt vmcnt(0) lgkmcnt(0)" ::: "memory");
  __syncthreads();
  if (threadIdx.x == 0) {
    target += gridDim.x;
    __builtin_amdgcn_fence(__ATOMIC_RELEASE, "agent");
    asm volatile("s_waitcnt vmcnt(0)" ::: "memory");
    __hip_atomic_fetch_add(bar, 1u, __ATOMIC_RELAXED, __HIP_MEMORY_SCOPE_AGENT);
    while (__hip_atomic_load(bar, __ATOMIC_RELAXED, __HIP_MEMORY_SCOPE_AGENT) < target) __builtin_amdgcn_s_sleep(1);
    __builtin_amdgcn_fence(__ATOMIC_ACQUIRE, "agent");
    asm volatile("s_waitcnt vmcnt(0)" ::: "memory");
  }
  __syncthreads();
}

constexpr int STG_LD = 136;
__device__ __forceinline__ int stg_idx(int r, int c) { return r * STG_LD + c + 4 * (c >> 6); }

template <class Epi, bool TS = false>
__device__ __forceinline__ void gemm_tile2(const bf16_t* __restrict__ A, int lda, const bf16_t* __restrict__ Bt, int ldb, int K,
                                           char* shm, const Epi& epi0, const Epi& epi1) {
  const int tid = otid(), wid = tid >> 6, lane = tid & 63, wr = wid >> 1, wc = wid & 1, fr = lane & 15, fq = lane >> 4;
  f32x4 acc[4][8];
#pragma unroll
  for (int m = 0; m < 4; ++m)
#pragma unroll
    for (int n = 0; n < 8; ++n) acc[m][n] = (f32x4){0.f, 0.f, 0.f, 0.f};
  const int srow = tid >> 3, sp = tid & 7, gch = sp ^ (srow & 7);
  const bf16_t* ga = A + (size_t)srow * lda + gch * 8;
  const bf16_t* gb = Bt + (size_t)srow * ldb + gch * 8;
  LAS char* l3 = (LAS char*)shm;
  LAS char* sA = l3; LAS char* sB = l3 + 65536;
  const int loff = tid * 16;
#define GLDS(buf, k0) do { \
    _Pragma("unroll") for (int j = 0; j < 4; ++j) { \
      __builtin_amdgcn_global_load_lds((const unsigned*)(ga + (size_t)(64 * j) * lda + (k0)), (LAS unsigned*)(sA + (buf) * 32768 + j * 8192 + loff), 16, 0, 0); \
      __builtin_amdgcn_global_load_lds((const unsigned*)(gb + (size_t)(64 * j) * ldb + (k0)), (LAS unsigned*)(sB + (buf) * 32768 + j * 8192 + loff), 16, 0, 0); } } while (0)
  __syncthreads();
  GLDS(0, 0);
  asm volatile("s_waitcnt vmcnt(0)" ::: "memory");
  __syncthreads();
  const int nk = K >> 6;
  const int aoff = (wr * 64 + fr) * 128, boff = (wc * 64 + fr) * 128, sw = fr & 7;
  for (int kt = 0; kt < nk; ++kt) {
    const int buf = kt & 1;
    if (kt + 1 < nk) GLDS(buf ^ 1, (kt + 1) << 6);
    const char* cA = shm + buf * 32768 + aoff; const char* cB = shm + 65536 + buf * 32768 + boff;
#pragma unroll
    for (int ks = 0; ks < 2; ++ks) {
      const int co = ((ks * 4 + fq) ^ sw) << 4;
      bf16x8 af[4], bfr[8];
#pragma unroll
      for (int m = 0; m < 4; ++m) af[m] = *(const bf16x8*)(cA + m * 2048 + co);
#pragma unroll
      for (int n = 0; n < 8; ++n) bfr[n] = *(const bf16x8*)(cB + (n >> 2) * 16384 + (n & 3) * 2048 + co);
#pragma unroll
      for (int m = 0; m < 4; ++m)
#pragma unroll
        for (int n = 0; n < 8; ++n) acc[m][n] = __builtin_amdgcn_mfma_f32_16x16x32_bf16(af[m], bfr[n], acc[m][n], 0, 0, 0);
    }
    asm volatile("s_waitcnt vmcnt(0)" ::: "memory");
    __syncthreads();
  }
#undef GLDS
  float* stg = (float*)shm;
#pragma unroll
  for (int hb = 0; hb < 2; ++hb) {
    if (hb) __syncthreads();
    if constexpr (TS) {
#pragma unroll
      for (int m = 0; m < 4; ++m)
#pragma unroll
        for (int n = 0; n < 4; ++n)
          *(f32x4*)(stg + (wc * 64 + n * 16 + fr) * 260 + wr * 64 + m * 16 + fq * 4) = acc[m][hb * 4 + n];
    } else {
#pragma unroll
    for (int m = 0; m < 4; ++m)
#pragma unroll
      for (int n = 0; n < 4; ++n)
#pragma unroll
        for (int j = 0; j < 4; ++j)
          stg[(wr * 64 + m * 16 + fq * 4 + j) * STG_LD + wc * 68 + n * 16 + fr] = acc[m][hb * 4 + n][j];
    }
    __syncthreads();
    if (hb == 0) epi0(stg); else epi1(stg);
  }
}

__device__ __forceinline__ void ld64(const float* stg, int r, int hf, float (&v)[64]) {
  const float* p = stg + r * STG_LD + hf * 68;
#pragma unroll
  for (int j = 0; j < 16; ++j) { f32x4 t = *(const f32x4*)(p + 4 * j); v[4 * j] = t[0]; v[4 * j + 1] = t[1]; v[4 * j + 2] = t[2]; v[4 * j + 3] = t[3]; }
}
__device__ __forceinline__ void st64bf(bf16_t* dst, const float (&v)[64]) {
#pragma unroll
  for (int j = 0; j < 8; ++j) {
    u32x4 w = {cvtpk(v[8 * j], v[8 * j + 1]), cvtpk(v[8 * j + 2], v[8 * j + 3]), cvtpk(v[8 * j + 4], v[8 * j + 5]), cvtpk(v[8 * j + 6], v[8 * j + 7])};
    *(u32x4*)(dst + 8 * j) = w;
  }
}

struct EpiStoreBf16 {
  bf16_t* dst; int ld; const float* bias;
  __device__ __forceinline__ void operator()(const float* stg) const {
    const int tid_ = otid(); const int r = tid_ >> 1, hf = tid_ & 1;
    float v[64]; ld64(stg, r, hf, v);
    if (bias) {
#pragma unroll
      for (int j = 0; j < 64; ++j) v[j] += bias[hf * 64 + j];
    }
    st64bf(dst + (size_t)r * ld + hf * 64, v);
  }
};

struct EpiStoreF32 {
  float* dst; int ld;
  __device__ __forceinline__ void operator()(const float* stg) const {
    const int tid_ = otid(); const int rr = tid_ >> 5, c4 = (tid_ & 31) * 4;
    const float* sp = stg + c4 + 4 * (c4 >> 6);
#pragma unroll 4
    for (int i = 0; i < 16; ++i) { const int r = rr + 16 * i; *(f32x4*)(dst + (size_t)r * ld + c4) = *(const f32x4*)(sp + r * STG_LD); }
  }
};

struct EpiPQT {
  bf16_t* dst;
  __device__ __forceinline__ void operator()(const float* stg) const {
    const int tid_ = otid(); const int dsel = tid_ >> 5, ch = tid_ & 31;
#pragma unroll
    for (int k = 0; k < 8; ++k) {
      const int d = dsel + 16 * k;
      const f32x4 a = *(const f32x4*)(stg + d * 260 + ch * 8), c = *(const f32x4*)(stg + d * 260 + ch * 8 + 4);
      *(u32x4*)(dst + (size_t)d * 4096 + ch * 8) = (u32x4){cvtpk(a[0], a[1]), cvtpk(a[2], a[3]), cvtpk(c[0], c[1]), cvtpk(c[2], c[3])};
    }
  }
};

struct EpiInProj {
  int kind;
  int b, l0;
  int isctx;
  int head;
  int g, ab, dh;
  const float* gq; const float* gk; const float* rope;
  bf16_t *Qb, *Kb, *Vb, *PQt, *Fb; int row0, fcol;
  __device__ __forceinline__ void operator()(const float* stg) const {
    const int tid = otid();
    if (kind == 3) {
      const int dcol = tid & 127, lq = tid >> 7;
      const int d = dh * 128 + dcol;
      bf16_t* dst = PQt + ((size_t)((b * 4 + g) * 256 + d)) * 4096 + ab * 2048 + l0;
      const float* p = stg + stg_idx(0, dcol);
#pragma unroll
      for (int ch = 0; ch < 8; ++ch) {
        const int lr = (lq * 8 + ch) * 8;
        float v[8];
#pragma unroll
        for (int jj = 0; jj < 8; ++jj) v[jj] = p[(lr + jj) * STG_LD];
        u32x4 w = {cvtpk(v[0], v[1]), cvtpk(v[2], v[3]), cvtpk(v[4], v[5]), cvtpk(v[6], v[7])};
        *(u32x4*)(dst + lr) = w;
      }
      return;
    }
    const int r = tid >> 1, hf = tid & 1;
    float v[64]; ld64(stg, r, hf, v);
    if (kind == 4) { st64bf(Fb + (size_t)(row0 + r) * 1024 + fcol + hf * 64, v); return; }
    if (kind == 2) {
      st64bf(Vb + ((size_t)((b * 2 + head) * LK) + (isctx ? SEQ : l0) + r) * 128 + hf * 64, v);
      return;
    }
    float ss = 0.f;
#pragma unroll
    for (int j = 0; j < 64; ++j) ss += v[j] * v[j];
    ss += xor1_f(ss);
    const float rs = rsqrtf(ss * (1.f / 128.f) + EPS);
    const float* gg = (kind == 0 ? gq : gk) + hf * 64;
#pragma unroll
    for (int j = 0; j < 64; ++j) v[j] = v[j] * rs * gg[j];
    if (!isctx) {
      const int l = l0 + r, pos = hf == 0 ? (l >> 6) : (l & 63);
      const float* rp = rope + pos * 64;
#pragma unroll
      for (int j = 0; j < 32; ++j) {
        const float cs = rp[2 * j], sn = rp[2 * j + 1], x1 = v[j], x2 = v[j + 32];
        v[j] = x1 * cs - x2 * sn; v[j + 32] = x2 * cs + x1 * sn;
      }
    }
    if (kind == 0) st64bf(Qb + ((size_t)((b * 8 + head) * SEQ) + l0 + r) * 128 + hf * 64, v);
    else           st64bf(Kb + ((size_t)((b * 2 + head) * LK) + (isctx ? SEQ : l0) + r) * 128 + hf * 64, v);
  }
};

struct EpiOutProj {
  const float* x; const float* gt1; float* xl;
  const float* g2; const float* sc2; bf16_t* a2; float* ssq;
  __device__ __forceinline__ void operator()(const float* stg) const {
    const int tid_ = otid(); const int rr = tid_ >> 5, c4 = (tid_ & 31) * 4;
    const f32x4 gv = *(const f32x4*)(gt1 + c4);
    const f32x4 gn = *(const f32x4*)(g2 + c4), sv = *(const f32x4*)(sc2 + c4);
    const f32x4 gs = {gn[0] * (1.f + sv[0]), gn[1] * (1.f + sv[1]), gn[2] * (1.f + sv[2]), gn[3] * (1.f + sv[3])};
    const float* sp = stg + c4 + 4 * (c4 >> 6);
#pragma unroll 4
    for (int i = 0; i < 16; ++i) {
      const int r = rr + 16 * i;
      const f32x4 a = *(const f32x4*)(sp + r * STG_LD), xv = __builtin_nontemporal_load((const f32x4*)(x + (size_t)r * DM + c4));
      f32x4 ov; ov[0] = xv[0] + gv[0] * a[0]; ov[1] = xv[1] + gv[1] * a[1]; ov[2] = xv[2] + gv[2] * a[2]; ov[3] = xv[3] + gv[3] * a[3];
      *(f32x4*)(xl + (size_t)r * DM + c4) = ov;
      *(u32x2*)(a2 + (size_t)r * DM + c4) = (u32x2){cvtpk(ov[0] * gs[0], ov[1] * gs[1]), cvtpk(ov[2] * gs[2], ov[3] * gs[3])};
      float s = ov[0] * ov[0] + ov[1] * ov[1] + ov[2] * ov[2] + ov[3] * ov[3];
      s += dpp_f<0xB1>(s); s += dpp_f<0x4E>(s); s += dpp_f<0x141>(s); s += dpp_f<0x140>(s);
      { auto q = __builtin_amdgcn_permlane16_swap(__float_as_uint(s), __float_as_uint(s), false, false); s = __uint_as_float(q[0]) + __uint_as_float(q[1]); }
      if ((tid_ & 31) == 0) ssq[(size_t)r * 16] = s;
    }
  }
};

#define CE(a, b) do { float _h = fmaxf(a, b), _l = fminf(a, b); a = _h; b = _l; } while (0)
struct EpiTopk {
  unsigned* topk; int row0, seg;
  const float* ssq; const float* cvec;
  __device__ __forceinline__ void operator()(const float* stg) const {
    const int tid_ = otid(); const int r = tid_ >> 1, hf = tid_ & 1;
    const float* p = stg + r * STG_LD + hf * 68;
    float rstd;
    { const float* sq = ssq + (size_t)(row0 + r) * 16; float s = 0.f;
#pragma unroll
      for (int j4 = 0; j4 < 4; ++j4) { const f32x4 t = *(const f32x4*)(sq + 4 * j4); s += t[0]; s += t[1]; s += t[2]; s += t[3]; }
      rstd = rsqrtf(s * (1.f / DM) + EPS); }
    const float* cv = cvec + hf * 64;
    float L[16];
#define BITONIC_MERGE16(X) do { \
    _Pragma("unroll") for (int i_ = 0; i_ < 8; ++i_) CE(X[i_], X[i_ + 8]); \
    _Pragma("unroll") for (int q_ = 0; q_ < 16; q_ += 8) { _Pragma("unroll") for (int i_ = 0; i_ < 4; ++i_) CE(X[q_ + i_], X[q_ + i_ + 4]); } \
    _Pragma("unroll") for (int q_ = 0; q_ < 16; q_ += 4) { _Pragma("unroll") for (int i_ = 0; i_ < 2; ++i_) CE(X[q_ + i_], X[q_ + i_ + 2]); } \
    _Pragma("unroll") for (int q_ = 0; q_ < 16; q_ += 2) CE(X[q_], X[q_ + 1]); } while (0)
#pragma unroll
    for (int ch = 0; ch < 4; ++ch) {
      float C[16];
#pragma unroll
      for (int j4 = 0; j4 < 4; ++j4) { const f32x4 t = *(const f32x4*)(p + ch * 16 + 4 * j4); const f32x4 cb = *(const f32x4*)(cv + ch * 16 + 4 * j4);
#pragma unroll
        for (int e = 0; e < 4; ++e) C[4 * j4 + e] = __uint_as_float((__float_as_uint(fmaf(t[e], rstd, cb[e])) & ~127u) | (unsigned)(hf * 64 + ch * 16 + j4 * 4 + e)); }
#pragma unroll
      for (int k = 2; k <= 16; k <<= 1)
#pragma unroll
        for (int j = k >> 1; j > 0; j >>= 1)
#pragma unroll
          for (int i = 0; i < 16; ++i) { const int l = i ^ j; if (l > i) { if ((i & k) == 0) CE(C[i], C[l]); else CE(C[l], C[i]); } }
      if (ch == 0) {
#pragma unroll
        for (int i = 0; i < 16; ++i) L[i] = C[i];
      } else {
#pragma unroll
        for (int i = 0; i < 16; ++i) L[i] = fmaxf(L[i], C[15 - i]);
        BITONIC_MERGE16(L);
      }
    }
    float M[16];
#pragma unroll
    for (int i = 0; i < 16; ++i) M[i] = fmaxf(L[i], xor1_f(L[15 - i]));
#pragma unroll
    for (int i = 0; i < 8; ++i) CE(M[i], M[i + 8]);
#pragma unroll
    for (int q = 0; q < 16; q += 8)
#pragma unroll
      for (int i = 0; i < 4; ++i) CE(M[q + i], M[q + i + 4]);
#pragma unroll
    for (int q = 0; q < 16; q += 4)
#pragma unroll
      for (int i = 0; i < 2; ++i) CE(M[q + i], M[q + i + 2]);
#pragma unroll
    for (int q = 0; q < 16; q += 2) CE(M[q], M[q + 1]);
    unsigned* dst = topk + ((size_t)(row0 + r) * 16 + seg) * 16 + hf * 8;
    u32x4 w0, w1;
    if (hf == 0) { w0 = (u32x4){__float_as_uint(M[0]), __float_as_uint(M[1]), __float_as_uint(M[2]), __float_as_uint(M[3])};
                   w1 = (u32x4){__float_as_uint(M[4]), __float_as_uint(M[5]), __float_as_uint(M[6]), __float_as_uint(M[7])}; }
    else         { w0 = (u32x4){__float_as_uint(M[8]), __float_as_uint(M[9]), __float_as_uint(M[10]), __float_as_uint(M[11])};
                   w1 = (u32x4){__float_as_uint(M[12]), __float_as_uint(M[13]), __float_as_uint(M[14]), __float_as_uint(M[15])}; }
    *(u32x4*)dst = w0; *(u32x4*)(dst + 4) = w1;
  }
};

namespace attn {
constexpr int D = 128, NW = 8, QBLK = 32, KVBLK = 64;
constexpr float SCALE = 0.088388347648318440f;
constexpr float THR = 8.f;
constexpr int LDQ = 128, LDK = 128, LDO = DM;
constexpr size_t SHM_V = KVBLK * D * 2, SHM_K = KVBLK * D * 2;
#define KSWZ(row, colB) ((row) * 256 + ((colB) ^ (((row) & 7) << 4)))
#define SBAR() __builtin_amdgcn_sched_barrier(0)
__device__ __forceinline__ int crow(int r, int hi) { return (r & 3) + 8 * (r >> 2) + 4 * hi; }
__device__ __forceinline__ void partialSM(f32x16& p0, f32x16& p1, float& m_reg, float& mn, float& alpha) {
  constexpr float C = SCALE * 1.4426950408889634f;
  float pmax = p0[0];
#pragma unroll
  for (int r = 1; r < 16; ++r) pmax = fmaxf(pmax, p0[r]);
#pragma unroll
  for (int r = 0; r < 16; ++r) pmax = fmaxf(pmax, p1[r]);
  { auto rr = __builtin_amdgcn_permlane32_swap(__float_as_uint(pmax), __float_as_uint(pmax), false, false);
    pmax = fmaxf(__uint_as_float(rr[0]), __uint_as_float(rr[1])); }
  if (__builtin_expect(__all(pmax - m_reg <= THR / SCALE), 1)) { mn = m_reg; alpha = 1.f; }
  else { mn = fmaxf(m_reg, pmax); alpha = __builtin_amdgcn_exp2f((m_reg - mn) * C); m_reg = mn; }
  float mnC = -mn * C;
#pragma unroll
  for (int r = 0; r < 16; ++r) p0[r] = fmaf(p0[r], C, mnC);
#pragma unroll
  for (int r = 0; r < 16; ++r) p1[r] = fmaf(p1[r], C, mnC);
#pragma unroll
  for (int r = 0; r < 16; ++r) p0[r] = __builtin_amdgcn_exp2f(p0[r]);
}
__device__ __forceinline__ void finishSM(f32x16& p0, f32x16& p1, float alpha, float& l_reg, bf16x8& pa0, bf16x8& pa1, bf16x8& pa2, bf16x8& pa3) {
#pragma unroll
  for (int r = 0; r < 16; ++r) p1[r] = __builtin_amdgcn_exp2f(p1[r]);
  float ps = 0;
#pragma unroll
  for (int r = 0; r < 16; ++r) ps += p0[r];
#pragma unroll
  for (int r = 0; r < 16; ++r) ps += p1[r];
  { auto rr = __builtin_amdgcn_permlane32_swap(__float_as_uint(ps), __float_as_uint(ps), false, false);
    ps = __uint_as_float(rr[0]) + __uint_as_float(rr[1]); }
  l_reg = l_reg * alpha + ps;
#define PK4(P, BASE, OUT) do { unsigned a0 = cvtpk(P[BASE + 0], P[BASE + 1]), a1 = cvtpk(P[BASE + 2], P[BASE + 3]);   \
    unsigned b0 = cvtpk(P[BASE + 4], P[BASE + 5]), b1 = cvtpk(P[BASE + 6], P[BASE + 7]);                              \
    auto r0 = __builtin_amdgcn_permlane32_swap(a0, b0, false, false); auto r1 = __builtin_amdgcn_permlane32_swap(a1, b1, false, false); \
    u32x4 w = {r0[0], r1[0], r0[1], r1[1]}; OUT = *reinterpret_cast<bf16x8*>(&w); } while (0)
  PK4(p0, 0, pa0); PK4(p0, 8, pa1); PK4(p1, 0, pa2); PK4(p1, 8, pa3);
#undef PK4
}
__device__ __forceinline__ void qkt(f32x16& p0, f32x16& p1, const char* Ks, const bf16x8* qr, int r32, int hi) {
  p0 = f32x16{}; p1 = f32x16{};
#pragma unroll
  for (int d0 = 0; d0 < 8; ++d0) { int cb = (d0 * 16 + hi * 8) * 2;
    bf16x8 b0 = *reinterpret_cast<const bf16x8*>(Ks + KSWZ(r32, cb));
    bf16x8 b1 = *reinterpret_cast<const bf16x8*>(Ks + KSWZ(32 + r32, cb));
    p0 = __builtin_amdgcn_mfma_f32_32x32x16_bf16(b0, qr[d0], p0, 0, 0, 0);
    p1 = __builtin_amdgcn_mfma_f32_32x32x16_bf16(b1, qr[d0], p1, 0, 0, 0); }
}
__device__ __forceinline__ int v_st(int k, int c) { const int kk = (k & ~0xC) | ((k & 4) << 1) | ((k & 8) >> 1); return ((kk >> 3) * 4 + (c >> 5)) * 512 + ((kk & 7) * 32 + (c & 31)) * 2; }
__device__ __forceinline__ int v_rd_base(int lane) { return ((lane & 3) << 3) | (((lane >> 2) & 3) << 6) | (((lane >> 4) & 1) << 5) | (((lane >> 5) & 1) << 8); }
constexpr int v_rd_off(int d0, int ks, int half) { return d0 * 512 + ks * 4096 + half * 2048; }
template <int OFF> __device__ __forceinline__ s16x4 tr_read(int vb) {
  s16x4 r; asm volatile("ds_read_b64_tr_b16 %0, %1 offset:%2" : "=&v"(r) : "v"(vb), "i"(OFF) : "memory"); return r;
}
template <int D0> __device__ __forceinline__ void pv_one(f32x16& od, int vb, bf16x8 pa0, bf16x8 pa1, bf16x8 pa2, bf16x8 pa3) {
  const s16x4 l0 = tr_read<v_rd_off(D0, 0, 0)>(vb), h0 = tr_read<v_rd_off(D0, 0, 1)>(vb), l1 = tr_read<v_rd_off(D0, 1, 0)>(vb), h1 = tr_read<v_rd_off(D0, 1, 1)>(vb);
  const s16x4 l2 = tr_read<v_rd_off(D0, 2, 0)>(vb), h2 = tr_read<v_rd_off(D0, 2, 1)>(vb), l3 = tr_read<v_rd_off(D0, 3, 0)>(vb), h3 = tr_read<v_rd_off(D0, 3, 1)>(vb);
  asm volatile("s_waitcnt lgkmcnt(0)" ::: "memory"); SBAR();
#define PK(L, H) (bf16x8){L[0], L[1], L[2], L[3], H[0], H[1], H[2], H[3]}
  od = __builtin_amdgcn_mfma_f32_32x32x16_bf16(pa0, PK(l0, h0), od, 0, 0, 0);
  od = __builtin_amdgcn_mfma_f32_32x32x16_bf16(pa1, PK(l1, h1), od, 0, 0, 0);
  od = __builtin_amdgcn_mfma_f32_32x32x16_bf16(pa2, PK(l2, h2), od, 0, 0, 0);
  od = __builtin_amdgcn_mfma_f32_32x32x16_bf16(pa3, PK(l3, h3), od, 0, 0, 0);
#undef PK
}
__device__ __forceinline__ void pv_d0(f32x16* o, int vb, bf16x8 pa0, bf16x8 pa1, bf16x8 pa2, bf16x8 pa3) {
  pv_one<0>(o[0], vb, pa0, pa1, pa2, pa3); pv_one<1>(o[1], vb, pa0, pa1, pa2, pa3); pv_one<2>(o[2], vb, pa0, pa1, pa2, pa3); pv_one<3>(o[3], vb, pa0, pa1, pa2, pa3);
}
__device__ __forceinline__ void body(const bf16_t* __restrict__ Qb, const bf16_t* __restrict__ Kh, const bf16_t* __restrict__ Vh,
                                     bf16_t* __restrict__ Ob, int seq, char* lds) {
  const int tid = otid(), wid = tid >> 6, lane = tid & 63, r32 = lane & 31, hi = lane >> 5;
  char* V_lds = lds; char* K_lds = lds + 2 * SHM_V;
  float* ws = (float*)(lds + 2 * SHM_V + 2 * SHM_K) + wid * 64; float* li_l = ws; float* al_l = ws + 32;
  float m_reg = -1e30f, l_reg = 0; f32x16 o[4] = {}; bf16x8 qr[8];
  const bf16_t* Qw = Qb + (long)(wid * QBLK + r32) * LDQ + hi * 8;
#pragma unroll
  for (int d0 = 0; d0 < 8; ++d0) qr[d0] = *(const bf16x8*)(Qw + d0 * 16);
  const int sr = tid >> 4, sc = (tid & 15) * 8, vst0 = v_st(sr, sc), vst1 = v_st(32 + sr, sc);
  const int vb0 = (int)(uintptr_t)V_lds + v_rd_base(lane);
  struct { bf16x8 vs0, vs1, ks0, ks1; } sr_[1];
#define SLOAD(i, k0) do { sr_[i].vs0 = *(const bf16x8*)(&Vh[(long)((k0) + sr) * LDK + sc]); sr_[i].vs1 = *(const bf16x8*)(&Vh[(long)((k0) + 32 + sr) * LDK + sc]); \
    sr_[i].ks0 = *(const bf16x8*)(&Kh[(long)((k0) + sr) * LDK + sc]); sr_[i].ks1 = *(const bf16x8*)(&Kh[(long)((k0) + 32 + sr) * LDK + sc]); } while (0)
#define SWRITE(b, i) do { *(bf16x8*)(V_lds + (b) * SHM_V + vst0) = sr_[i].vs0;          \
    *(bf16x8*)(V_lds + (b) * SHM_V + vst1) = sr_[i].vs1; int kc = sc * 2;               \
    *(bf16x8*)(K_lds + (b) * SHM_K + KSWZ(sr, kc)) = sr_[i].ks0;                       \
    *(bf16x8*)(K_lds + (b) * SHM_K + KSWZ(32 + sr, kc)) = sr_[i].ks1; } while (0)
#define SWAIT() asm volatile("s_waitcnt vmcnt(0)" ::: "memory")
#define RESC(a) do { if (__any((a) < 1.f)) { if (hi == 0) al_l[r32] = (a); asm volatile("s_waitcnt lgkmcnt(0)" ::: "memory"); \
    for (int d = 0; d < 4; ++d) for (int r = 0; r < 16; ++r) o[d][r] *= al_l[crow(r, hi)]; } } while (0)
  f32x16 pA0, pA1, pB0, pB1; float mnA, mnB, alA, alB; bf16x8 pa0, pa1, pa2, pa3; const int NTL = seq / KVBLK;
  constexpr int SE = 0, SO = 0;
  SLOAD(SE, 0); asm volatile("s_waitcnt vmcnt(0)" ::: "memory"); SWRITE(0, SE); __syncthreads();
  qkt(pA0, pA1, K_lds, qr, r32, hi); partialSM(pA0, pA1, m_reg, mnA, alA);
  SLOAD(SO, KVBLK);
  SWAIT(); SWRITE(1, SO); __syncthreads();
  for (int j = 1; j + 1 < NTL; j += 2) {
    SBAR(); qkt(pB0, pB1, K_lds + SHM_K, qr, r32, hi);
    finishSM(pA0, pA1, alA, l_reg, pa0, pa1, pa2, pa3); SBAR();
    SLOAD(SO, (j + 1) * KVBLK); SBAR();
    pv_d0(o, vb0, pa0, pa1, pa2, pa3); partialSM(pB0, pB1, m_reg, mnB, alB);
    __syncthreads(); SWAIT(); SWRITE(0, SE);
    RESC(alB); __syncthreads();
    SBAR(); qkt(pA0, pA1, K_lds, qr, r32, hi);
    finishSM(pB0, pB1, alB, l_reg, pa0, pa1, pa2, pa3); SBAR();
    SLOAD(SE, (j + 2) * KVBLK); SBAR();
    pv_d0(o, vb0 + (int)SHM_V, pa0, pa1, pa2, pa3); partialSM(pA0, pA1, m_reg, mnA, alA);
    __syncthreads(); SWAIT(); SWRITE(1, SO);
    RESC(alA); __syncthreads();
  }
  SBAR(); qkt(pB0, pB1, K_lds + SHM_K, qr, r32, hi);
  finishSM(pA0, pA1, alA, l_reg, pa0, pa1, pa2, pa3); SBAR();
  pv_d0(o, vb0, pa0, pa1, pa2, pa3); partialSM(pB0, pB1, m_reg, mnB, alB);
  __syncthreads(); RESC(alB);
  finishSM(pB0, pB1, alB, l_reg, pa0, pa1, pa2, pa3); SBAR();
  pv_d0(o, vb0 + (int)SHM_V, pa0, pa1, pa2, pa3);
  if (hi == 0) li_l[r32] = l_reg; asm volatile("s_waitcnt lgkmcnt(0)" ::: "memory");
  float rli[16];
#pragma unroll
  for (int r = 0; r < 16; ++r) rli[r] = __builtin_amdgcn_rcpf(li_l[crow(r, hi)]);
  bf16_t* Ow = Ob + (long)(wid * QBLK) * LDO;
#pragma unroll
  for (int r = 0; r < 16; ++r) { int orow = crow(r, hi);
#pragma unroll
    for (int d0 = 0; d0 < 4; ++d0) Ow[(long)orow * LDO + d0 * 32 + r32] = f2bf(o[d0][r] * rli[r]); }
#undef SLOAD
#undef SWRITE
#undef SWAIT
#undef RESC
  __syncthreads();
}
}

__device__ __forceinline__ void job_mod(const Params& p, int it, char* shm) {
  const int tid = otid(), w = tid >> 6, lane = tid & 63, rg = lane >> 4, cl = lane & 15;
  float* sc = (float*)shm;
  float* red = (float*)(shm + 73728);
  __syncthreads();
  for (int i = tid; i < 9 * 2048; i += NT) { int r = i >> 11, k = i & 2047; float v = r < 8 ? p.c[r * DM + k] : p.c_ctx[k]; sc[i] = silu(v); }
  __syncthreads();
  float a[9][4];
#pragma unroll
  for (int r = 0; r < 9; ++r)
#pragma unroll
    for (int q = 0; q < 4; ++q) a[r][q] = 0.f;
  const float* wp = p.w_ada + (size_t)(w * 256 + rg) * NMOD + it * 64 + cl * 4;
  const float* sp = sc + w * 256 + rg;
#pragma unroll 8
  for (int kk = 0; kk < 64; ++kk) {
    const f32x4 wv = __builtin_nontemporal_load((const f32x4*)(wp + (size_t)(kk * 4) * NMOD));
#pragma unroll
    for (int r = 0; r < 9; ++r) { const float s = sp[r * 2048 + kk * 4];
#pragma unroll
      for (int q = 0; q < 4; ++q) a[r][q] += s * wv[q]; }
  }
#pragma unroll
  for (int r = 0; r < 9; ++r)
#pragma unroll
    for (int q = 0; q < 4; ++q) { float v = a[r][q]; v += __shfl_xor(v, 16); v += __shfl_xor(v, 32); a[r][q] = v; }
  if (rg == 0) {
#pragma unroll
    for (int r = 0; r < 9; ++r) *(f32x4*)(red + (w * 9 + r) * 64 + cl * 4) = (f32x4){a[r][0], a[r][1], a[r][2], a[r][3]};
  }
  __syncthreads();
  float* mod = (float*)(p.ws + OFF_MOD);
  for (int o = tid; o < 576; o += NT) { const int r = o >> 6, cc = o & 63; float s = p.b_ada[it * 64 + cc];
#pragma unroll
    for (int ww = 0; ww < 8; ++ww) s += red[(ww * 9 + r) * 64 + cc];
    mod[r * NMOD + it * 64 + cc] = s; }
}
__device__ __forceinline__ void job_transpose(const float* src, int ld, int coff, bf16_t* dst, int ldd, int tr, int tc, char* shm) {
  float* s = (float*)shm;
  const int tid = otid();
  const int r = tid >> 3, c8 = (tid & 7) * 8;
  __syncthreads();
  { const float* g = src + (size_t)(tr * 64 + r) * ld + coff + tc * 64 + c8;
    const f32x4 a = __builtin_nontemporal_load((const f32x4*)g), b = __builtin_nontemporal_load((const f32x4*)(g + 4));
    float* sp = s + r * 65 + c8;
    sp[0] = a[0]; sp[1] = a[1]; sp[2] = a[2]; sp[3] = a[3]; sp[4] = b[0]; sp[5] = b[1]; sp[6] = b[2]; sp[7] = b[3]; }
  __syncthreads();
  { const int n = r, k8 = c8;
    const float* sp = s + k8 * 65 + n;
    const u32x4 w = {cvtpk(sp[0], sp[65]), cvtpk(sp[130], sp[195]), cvtpk(sp[260], sp[325]), cvtpk(sp[390], sp[455])};
    *(u32x4*)(dst + (size_t)(tc * 64 + n) * ldd + tr * 64 + k8) = w; }
}
__device__ __forceinline__ unsigned quant_pack8(const float* v, float inv, int off, int& qsum) {
  unsigned pk = 0;
#pragma unroll
  for (int b = 0; b < 4; ++b) {
    int lo = (int)floorf(v[b] * inv), hi = (int)floorf(v[4 + b] * inv);
    lo = max(-8, min(7, lo)); hi = max(-8, min(7, hi)); qsum += lo + hi; lo += off; hi += off;
    pk |= ((unsigned)lo & 15u) << (8 * b); pk |= ((unsigned)hi & 15u) << (8 * b + 4);
  }
  return pk;
}
__device__ __forceinline__ unsigned quant_pack8_fp4(const float* v, float inv) {
  unsigned pk = 0;
#pragma unroll
  for (int b = 0; b < 8; ++b) {
    const float y = v[b] * inv, a = fabsf(y);
    unsigned c = (a > 0.25f) + (a > 0.75f) + (a > 1.25f) + (a > 1.75f) + (a > 2.5f) + (a > 3.5f) + (a > 5.0f);
    c |= y < 0.f ? 8u : 0u;
    pk |= c << (b < 4 ? 8 * b : 8 * (b - 4) + 4);
  }
  return pk;
}
__device__ __forceinline__ void job_quant_rows2(const float* src, unsigned char* dstq, float* dsts, int* dsum, int row, int lane, int off) {
  const float* r = src + (size_t)row * DM;
  float v[2][32];
#pragma unroll
  for (int k = 0; k < 2; ++k)
#pragma unroll
    for (int i = 0; i < 8; ++i) { f32x4 t = __builtin_nontemporal_load((const f32x4*)(r + k * DM + i * 256 + lane * 4)); v[k][4 * i] = t[0]; v[k][4 * i + 1] = t[1]; v[k][4 * i + 2] = t[2]; v[k][4 * i + 3] = t[3]; }
  float ss[2] = {0.f, 0.f};
#pragma unroll
  for (int k = 0; k < 2; ++k)
#pragma unroll
    for (int j = 0; j < 32; ++j) ss[k] += v[k][j] * v[k][j];
  ss[0] = wave_sum(ss[0]); ss[1] = wave_sum(ss[1]);
#pragma unroll
  for (int k = 0; k < 2; ++k) {
    const float rms = sqrtf(ss[k] * (1.f / DM));
    const float step = rms > 0.f ? (off == 8 ? 0.48f : 0.3352f) * rms : 1.f, inv = 1.f / step;
    int qs = 0;
    u32x4 w;
    if (off == 8) w = (u32x4){quant_pack8_fp4(&v[k][0], inv), quant_pack8_fp4(&v[k][8], inv), quant_pack8_fp4(&v[k][16], inv), quant_pack8_fp4(&v[k][24], inv)};
    else w = (u32x4){quant_pack8(&v[k][0], inv, off, qs), quant_pack8(&v[k][8], inv, off, qs), quant_pack8(&v[k][16], inv, off, qs), quant_pack8(&v[k][24], inv, off, qs)};
    *(u32x4*)(dstq + (size_t)(row + k) * 1024 + lane * 16) = w;
    qs = wave_sum_i(qs);
    if (lane == 0) { dsts[row + k] = step; if (dsum) dsum[row + k] = qs; }
  }
}

constexpr int J0 = 0, J1 = J0 + 192, J2 = J1 + 1280, J3 = J2 + 1024, J4 = J3 + 0, J5 = J4 + 1024, J6 = J5 + 128, J7 = J6 + 256,
              J8 = J7 + 512, J9 = J8 + 1, JEND = J9;

__device__ void phase0(const Params& p, char* shm) {
  const int tid = otid(), wid = tid >> 6, lane = tid & 63;
  for (int it = blockIdx.x; it < JEND; it += gridDim.x) {
    if (it < J1) job_mod(p, it - J0, shm);
    else if (it < J2) { int t = it - J1; job_transpose(p.w_in, 2560, 0, (bf16_t*)(p.ws + OFF_WINT), DM, t / 40, t % 40, shm); }
    else if (it < J3) { int t = it - J2; job_transpose(p.w_out, DM, 0, (bf16_t*)(p.ws + OFF_WOUTT), DM, t / 32, t % 32, shm); }
    else if (it < J4) {
      int base = (it - J3) * 4096 + tid * 8; int j = base >> 10, c = base & 1023;
      const float* s = p.w_in + (size_t)j * 2560 + 1536 + c; f32x4 a = *(const f32x4*)s, b = *(const f32x4*)(s + 4);
      *(u32x4*)((bf16_t*)(p.ws + OFF_WFIN) + base) = (u32x4){cvtpk(a[0], a[1]), cvtpk(a[2], a[3]), cvtpk(b[0], b[1]), cvtpk(b[2], b[3])};
    } else if (it < J5) {
      int base = (it - J4) * 4096 + tid * 8; const float* s = p.w_query + base; f32x4 a = *(const f32x4*)s, b = *(const f32x4*)(s + 4);
      *(u32x4*)((bf16_t*)(p.ws + OFF_WQ) + base) = (u32x4){cvtpk(a[0], a[1]), cvtpk(a[2], a[3]), cvtpk(b[0], b[1]), cvtpk(b[2], b[3])};
    } else if (it < J6) {
      int base = (it - J5) * 4096 + tid * 8; int row = base >> 8, col = base & 255; int hp = row >> 7;
      u32x4 w = {0u, 0u, 0u, 0u};
      if ((col >> 7) == (hp & 1)) { const float* s = p.sub_keys + (size_t)row * 128 + (col & 127); f32x4 a = *(const f32x4*)s, b = *(const f32x4*)(s + 4);
        w = (u32x4){cvtpk(a[0], a[1]), cvtpk(a[2], a[3]), cvtpk(b[0], b[1]), cvtpk(b[2], b[3])}; }
      *(u32x4*)((bf16_t*)(p.ws + OFF_SKBD) + base) = w;
    } else if (it < J7) {
      const int t = it - J6; const int g = t >> 6, ab = (t >> 5) & 1, c = (t & 31) * 8 + wid;
      float* tb = (float*)shm;
      __syncthreads();
      if (tid < 256) { float ang = (float)tid * (1.f / 128.f); tb[tid] = ab ? sinpif(ang) : cospif(ang); }
      __syncthreads();
      const float* wf = p.w_fourier + (size_t)g * 65536 + lane * 4;
      f32x4 a4 = {0.f, 0.f, 0.f, 0.f};
#pragma unroll 16
      for (int m = 0; m < 256; ++m) { const f32x4 wv = *(const f32x4*)(wf + m * 256); const float tv = tb[(m * c) & 255];
        a4[0] += tv * wv[0]; a4[1] += tv * wv[1]; a4[2] += tv * wv[2]; a4[3] += tv * wv[3]; }
      bf16_t* o = (bf16_t*)(p.ws + OFF_ABT) + ((size_t)(g * 512 + ab * 256 + lane * 4)) * 256 + c;
#pragma unroll
      for (int q = 0; q < 4; ++q) o[q * 256] = f2bf(a4[q] * 0.0013810679320049757f);
    } else if (it < J8) {
      int base = (it - J7) * 16384 + tid * 8;
      for (int rep = 0; rep < 4; ++rep, base += 4096) {
        int k = base >> 12, cl = base & 4095; unsigned w[4];
#pragma unroll
        for (int e = 0; e < 4; ++e) { float v2[2];
#pragma unroll
          for (int q = 0; q < 2; ++q) { int col = cl + e * 2 + q; int l = col & 2047; float ang = (float)((k * l) & 2047) * (1.f / 1024.f); v2[q] = (col >> 11) ? -sinpif(ang) : cospif(ang); }
          w[e] = cvtpk(v2[0], v2[1]); }
        *(u32x4*)((bf16_t*)(p.ws + OFF_TTAB) + base) = (u32x4){w[0], w[1], w[2], w[3]};
      }
    } else if (it < J9) {
      float* rt = (float*)(p.ws + OFF_ROPE);
      for (int i = tid; i < 2048; i += NT) { int pos = i >> 5, j = i & 31; float inv = powf(10000.f, -(float)j / 32.f); float ang = (float)pos * inv; rt[2 * i] = cosf(ang); rt[2 * i + 1] = sinf(ang); }
    }
  }
}
__device__ __forceinline__ void quant_item(const Params& p, int q) {
  const int tid = otid(), wid = tid >> 6, lane = tid & 63;
  const int row = (q & 1023) * 16 + wid * 2;
  if (q < 1024) job_quant_rows2(p.u_exp, (unsigned char*)(p.ws + OFF_UQ), (float*)(p.ws + OFF_US), (int*)(p.ws + OFF_USUM), row, lane, 0);
  else          job_quant_rows2(p.v_exp, (unsigned char*)(p.ws + OFF_VQ), (float*)(p.ws + OFF_VS), nullptr, row, lane, 8);
}

__device__ __forceinline__ void norm_mod_row2(const float* xr, const float* g, const float* sh, const float* sc, bf16_t* dst, int lane) {
  float v[2][32];
#pragma unroll
  for (int k = 0; k < 2; ++k)
#pragma unroll
    for (int i = 0; i < 8; ++i) { f32x4 t = __builtin_nontemporal_load((const f32x4*)(xr + k * DM + i * 256 + lane * 4)); v[k][4 * i] = t[0]; v[k][4 * i + 1] = t[1]; v[k][4 * i + 2] = t[2]; v[k][4 * i + 3] = t[3]; }
  float ss0 = 0.f, ss1 = 0.f;
#pragma unroll
  for (int j = 0; j < 32; ++j) { ss0 += v[0][j] * v[0][j]; ss1 += v[1][j] * v[1][j]; }
  ss0 = wave_sum(ss0); ss1 = wave_sum(ss1);
  const float rs0 = rsqrtf(ss0 * (1.f / DM) + EPS), rs1 = rsqrtf(ss1 * (1.f / DM) + EPS);
#pragma unroll
  for (int i = 0; i < 8; ++i) {
    const int c = i * 256 + lane * 4;
    const f32x4 gv = *(const f32x4*)(g + c), sv = *(const f32x4*)(sh + c), cv = *(const f32x4*)(sc + c);
    float m[4];
#pragma unroll
    for (int q = 0; q < 4; ++q) m[q] = gv[q] * (1.f + cv[q]);
    *(u32x2*)(dst + c) = (u32x2){cvtpk(v[0][4 * i] * rs0 * m[0] + sv[0], v[0][4 * i + 1] * rs0 * m[1] + sv[1]), cvtpk(v[0][4 * i + 2] * rs0 * m[2] + sv[2], v[0][4 * i + 3] * rs0 * m[3] + sv[3])};
    *(u32x2*)(dst + DM + c) = (u32x2){cvtpk(v[1][4 * i] * rs1 * m[0] + sv[0], v[1][4 * i + 1] * rs1 * m[1] + sv[1]), cvtpk(v[1][4 * i + 2] * rs1 * m[2] + sv[2], v[1][4 * i + 3] * rs1 * m[3] + sv[3])};
  }
}

__device__ __forceinline__ void peer_wave8(const Params& p, int tbase, int tstride, int ntok, char* wlds, int lane) {
  unsigned* keys = (unsigned*)wlds; int* eidxU = (int*)(wlds + 1024); float* gateU = (float*)(wlds + 1536);
  float* cand = (float*)(wlds + 2048); float* tokf = (float*)(wlds + 2304);
  unsigned short* eidxS = (unsigned short*)(wlds + 2560); float* gw = (float*)(wlds + 4608); int* red = (int*)(wlds + 8704);
  const float* mod = (const float*)(p.ws + OFF_MOD);
  unsigned* H2Q = (unsigned*)(p.ws + OFF_F);
  const unsigned char* Uq = (const unsigned char*)(p.ws + OFF_UQ); const float* Us = (const float*)(p.ws + OFF_US);
  const unsigned char* Vq = (const unsigned char*)(p.ws + OFF_VQ); const float* Vs = (const float*)(p.ws + OFF_VS);
  int ci = 0, cj = 0;
  { int cnt = 0;
#pragma unroll
    for (int i = 0; i < 16; ++i) { const int nj = 16 / (i + 1); if (lane >= cnt) { ci = i; cj = lane - cnt; } cnt += nj; } }
  asm volatile("" : "+v"(ci), "+v"(cj));
  const bool valid = lane < 50;
  for (int ti = 0; ti < ntok; ++ti) {
    const int t = tbase + ti * tstride, b = t >> 11;
    const unsigned* tk = (const unsigned*)(p.ws + OFF_TOPK) + (size_t)t * 256;
#pragma unroll
    for (int i = 0; i < 4; ++i) keys[i * 64 + lane] = tk[i * 64 + lane];
    __builtin_amdgcn_s_waitcnt(0xc07f);
    for (int h = 0; h < 8; ++h) {
      unsigned k1 = keys[(2 * h) * 16 + ci], k2 = keys[(2 * h + 1) * 16 + cj];
      float sv = __uint_as_float(k1 & ~127u) + __uint_as_float(k2 & ~127u);
      sv = valid ? __uint_as_float((__float_as_uint(sv) & ~63u) | (unsigned)(63 - lane)) : -3.0e38f;
      cand[lane] = sv;
      __builtin_amdgcn_s_waitcnt(0xc07f);
      int rank = 0;
#pragma unroll
      for (int o4 = 0; o4 < 13; ++o4) { f32x4 ov = *(const f32x4*)(cand + o4 * 4);
#pragma unroll
        for (int q = 0; q < 4; ++q) rank += (ov[q] > sv) ? 1 : 0; }
      const float mx = wave_max(sv);
      const bool sel = valid && rank < 16;
      float e = sel ? __expf(sv - mx) : 0.f;
      float se = wave_sum(e);
      if (sel) { eidxU[h * 16 + rank] = (int)((k1 & 127u) * 128u + (k2 & 127u)); gateU[h * 16 + rank] = e / se; }
    }
    __builtin_amdgcn_s_waitcnt(0xc07f);
    {
      const int e0 = eidxU[lane], e1 = eidxU[64 + lane]; const float g0 = gateU[lane], g1 = gateU[64 + lane];
      const int b0 = e0 >> 11, b1 = e1 >> 11;
      int pos0 = 0, pos1 = 0, base = 0;
#pragma unroll
      for (int bk = 0; bk < 8; ++bk) {
        const unsigned long long m0 = __ballot(b0 == bk), m1 = __ballot(b1 == bk);
        const int c0 = __popcll(m0), c1 = __popcll(m1);
        const int r0 = __builtin_amdgcn_mbcnt_hi((unsigned)(m0 >> 32), __builtin_amdgcn_mbcnt_lo((unsigned)m0, 0u));
        const int r1 = __builtin_amdgcn_mbcnt_hi((unsigned)(m1 >> 32), __builtin_amdgcn_mbcnt_lo((unsigned)m1, 0u));
        if (b0 == bk) pos0 = base + r0;
        if (b1 == bk) pos1 = base + c0 + r1;
        base += c0 + c1;
      }
      eidxS[ti * 128 + pos0] = (unsigned short)e0; gw[ti * 128 + pos0] = g0;
      eidxS[ti * 128 + pos1] = (unsigned short)e1; gw[ti * 128 + pos1] = g1;
    }
    const float* xrow = p.out + (size_t)t * DM;
    float xv[32];
#pragma unroll
    for (int i = 0; i < 8; ++i) { f32x4 tt = *(const f32x4*)(xrow + i * 256 + lane * 4); xv[4 * i] = tt[0]; xv[4 * i + 1] = tt[1]; xv[4 * i + 2] = tt[2]; xv[4 * i + 3] = tt[3]; }
    float ss = 0.f;
#pragma unroll
    for (int j = 0; j < 32; ++j) ss += xv[j] * xv[j];
    ss = wave_sum(ss);
    const float rs = rsqrtf(ss * (1.f / DM) + EPS);
    const float* sh2 = mod + b * NMOD + 3 * DM; const float* sc2 = mod + b * NMOD + 4 * DM;
    float hss = 0.f;
#pragma unroll
    for (int i = 0; i < 8; ++i) { const int c = i * 256 + lane * 4;
      const f32x4 g2 = *(const f32x4*)(p.g_norm2 + c), s2 = *(const f32x4*)(sc2 + c), h2 = *(const f32x4*)(sh2 + c);
#pragma unroll
      for (int q = 0; q < 4; ++q) { float hh = xv[4 * i + q] * rs * g2[q] * (1.f + s2[q]) + h2[q]; xv[4 * i + q] = hh; hss += hh * hh; } }
    hss = wave_sum(hss);
    const float hrms = sqrtf(hss * (1.f / DM));
    const float hsc = hrms > 0.f ? 0.3352f * hrms : 1.f, hinv = 1.f / hsc;
    int hsum = 0;
    const u32x4 hq4 = {quant_pack8(&xv[0], hinv, 0, hsum), quant_pack8(&xv[8], hinv, 0, hsum), quant_pack8(&xv[16], hinv, 0, hsum), quant_pack8(&xv[24], hinv, 0, hsum)};
    hsum = wave_sum_i(hsum);
    *(u32x4*)(H2Q + ((size_t)t * 64 + lane) * 4) = hq4;
    if (lane == 0) { tokf[ti * 2] = hsc; tokf[ti * 2 + 1] = (float)hsum; }
  }
  asm volatile("s_waitcnt vmcnt(0) lgkmcnt(0)" ::: "memory");
  u32x4 rA[16], rB[16]; u32x4 qA0, qA1, qB0, qB1;
  const int* Usum = (const int*)(p.ws + OFF_USUM);
#define ULOAD(R, Q0, Q1, S) do { const int j_ = (S) / ntok, ti_ = (S) - j_ * ntok; const int t_ = tbase + ti_ * tstride; \
    Q0 = *(const u32x4*)(H2Q + ((size_t)t_ * 64 + lane) * 4); \
    _Pragma("unroll") for (int i = 0; i < 16; ++i) { const int e_ = eidxS[ti_ * 128 + j_ * 16 + i]; R[i] = *(const u32x4*)(Uq + (size_t)e_ * 1024 + lane * 16); } } while (0)
#define UCOMP(R, Q0, Q1, S) do { const int j_ = (S) / ntok, ti_ = (S) - j_ * ntok; \
    _Pragma("unroll") for (int i = 0; i < 16; ++i) { int d_ = 0; \
      _Pragma("unroll") for (int q = 0; q < 4; ++q) d_ = __builtin_amdgcn_sdot8((int)Q0[q], (int)R[i][q], d_, false); \
      red[i * 64 + lane] = d_; } \
    __builtin_amdgcn_s_waitcnt(0xc07f); \
    const int ee_ = lane >> 2, sub_ = lane & 3; const int* rp_ = red + ee_ * 64 + sub_ * 16; int dd_ = 0; \
    _Pragma("unroll") for (int q = 0; q < 4; ++q) { const u32x4 qq_ = *(const u32x4*)(rp_ + 4 * q); dd_ += (int)qq_[0] + (int)qq_[1] + (int)qq_[2] + (int)qq_[3]; } \
    dd_ += xor1_i(dd_); dd_ += xor2_i(dd_); \
    const int k_ = ti_ * 128 + j_ * 16 + ee_, e2_ = eidxS[k_]; \
    const float pre_ = ((float)dd_ + 0.5f * (float)Usum[e2_] + 0.5f * tokf[ti_ * 2 + 1] + 512.f) * tokf[ti_ * 2] * Us[e2_]; \
    const float a_ = 0.5f * pre_ * (1.f + erff(pre_ * 0.70710678118654752f)); \
    const float w_ = gw[k_] * a_ * Vs[e2_]; \
    __builtin_amdgcn_s_waitcnt(0xc07f); \
    if (sub_ == 0) gw[k_] = w_; } while (0)
  {
    const int S = 8 * ntok;
    ULOAD(rA, qA0, qA1, 0);
    for (int s = 0; s < S; s += 2) {
      ULOAD(rB, qB0, qB1, s + 1); SBAR();
      UCOMP(rA, qA0, qA1, s); SBAR();
      if (s + 2 < S) ULOAD(rA, qA0, qA1, s + 2);
      SBAR();
      UCOMP(rB, qB0, qB1, s + 1); SBAR();
    }
  }
#undef ULOAD
#undef UCOMP
  __builtin_amdgcn_s_waitcnt(0xc07f);
  int laneC = lane; asm volatile("" : "+v"(laneC));
#define VLOAD(R, TI, KB) do { _Pragma("unroll") for (int i = 0; i < 4; ++i) { const int e_ = eidxS[(TI) * 128 + (KB) * 4 + i]; R[i] = *(const u32x4*)(Vq + (size_t)e_ * 1024 + laneC * 16); } } while (0)
#define VCOMP(ACC, R, TI, KB) do { \
    _Pragma("unroll") for (int i = 0; i < 4; ++i) { const float w_ = gw[(TI) * 128 + (KB) * 4 + i]; const f2_t w2_ = {w_, w_}; \
      _Pragma("unroll") for (int q = 0; q < 4; ++q) { const unsigned x_ = R[i][q]; \
        ACC[4 * q + 0] = __builtin_elementwise_fma(__builtin_amdgcn_cvt_scalef32_pk_f32_fp4(x_, 1.0f, 0), w2_, ACC[4 * q + 0]); \
        ACC[4 * q + 1] = __builtin_elementwise_fma(__builtin_amdgcn_cvt_scalef32_pk_f32_fp4(x_, 1.0f, 1), w2_, ACC[4 * q + 1]); \
        ACC[4 * q + 2] = __builtin_elementwise_fma(__builtin_amdgcn_cvt_scalef32_pk_f32_fp4(x_, 1.0f, 2), w2_, ACC[4 * q + 2]); \
        ACC[4 * q + 3] = __builtin_elementwise_fma(__builtin_amdgcn_cvt_scalef32_pk_f32_fp4(x_, 1.0f, 3), w2_, ACC[4 * q + 3]); } } } while (0)
#define VFINAL(ACC, TI) do { const int t_ = tbase + (TI) * tstride, b_ = t_ >> 11; \
    float* xrow_ = p.out + (size_t)t_ * DM; const float* gt2_ = mod + b_ * NMOD + 5 * DM; float ss2_ = 0.f; \
    _Pragma("unroll") for (int i = 0; i < 8; ++i) { const int c = i * 256 + laneC * 4; const f32x4 g4 = *(const f32x4*)(gt2_ + c), x4 = __builtin_nontemporal_load((const f32x4*)(xrow_ + c)); \
      _Pragma("unroll") for (int q = 0; q < 4; ++q) { float y = x4[q] + g4[q] * ACC[4 * (i >> 1) + q][i & 1]; ACC[4 * (i >> 1) + q][i & 1] = y; ss2_ += y * y; } } \
    ss2_ = wave_sum(ss2_); const float rs2_ = rsqrtf(ss2_ * (1.f / DM) + EPS); \
    _Pragma("unroll") for (int i = 0; i < 8; ++i) { const int c = i * 256 + laneC * 4; const f32x4 gf = *(const f32x4*)(p.g_final + c); f32x4 ov; \
      ov[0] = ACC[4 * (i >> 1)][i & 1] * rs2_ * gf[0]; ov[1] = ACC[4 * (i >> 1) + 1][i & 1] * rs2_ * gf[1]; ov[2] = ACC[4 * (i >> 1) + 2][i & 1] * rs2_ * gf[2]; ov[3] = ACC[4 * (i >> 1) + 3][i & 1] * rs2_ * gf[3]; \
      __builtin_nontemporal_store(ov, (f32x4*)(xrow_ + c)); } } while (0)
  for (int pg = 0; pg < ntok; pg += 2) {
    const int tiA = pg, tiB = pg + 1 < ntok ? pg + 1 : pg;
    f2_t accA[16], accB[16];
#pragma unroll
    for (int j = 0; j < 16; ++j) { accA[j] = (f2_t){0.f, 0.f}; accB[j] = (f2_t){0.f, 0.f}; }
    VLOAD(rA, tiA, 0);
    for (int j = 0; j < 32; ++j) {
      VLOAD(rB, tiB, j); SBAR();
      VCOMP(accA, rA, tiA, j); SBAR();
      if (j + 1 < 32) VLOAD(rA, tiA, j + 1);
      SBAR();
      VCOMP(accB, rB, tiB, j); SBAR();
    }
    VFINAL(accA, tiA);
    if (pg + 1 < ntok) VFINAL(accB, tiB);
  }
#undef VFINAL
#undef VLOAD
#undef VCOMP
}

__global__ void __launch_bounds__(NT) mega(Params p) {
  cg::grid_group grid = cg::this_grid();
  extern __shared__ __attribute__((aligned(16))) char shm[];
  const int G = gridDim.x, bid = blockIdx.x;
  char* ws = p.ws;
  const float* mod = (const float*)(ws + OFF_MOD);
  bf16_t* WinT = (bf16_t*)(ws + OFF_WINT);
  bf16_t* Hb = (bf16_t*)(ws + OFF_H); bf16_t* HCb = (bf16_t*)(ws + OFF_HC);
  unsigned* gbar = (unsigned*)(ws + OFF_BAR); unsigned gtarget = 0; (void)gtarget;
  volatile LAS unsigned* xst = (volatile LAS unsigned*)(LAS char*)(shm + DYN_LDS - 16);
  if (threadIdx.x == 0) { xst[0] = 0u; xst[1] = 0u; }
  __syncthreads();
  const XcdBarrier xb = xcd_barrier_post(gbar, xst);

  REPS(0) phase0(p, shm);
  if (p.ws == nullptr) grid.sync();
  xcd_barrier(xb);

  REPS(1) for (int it = bid; it < 64 + 1152; it += G) {
    if (false) {
    } else if (it < 64) {
      const int t2 = it, tm = t2 >> 3, tn = t2 & 7;
      bf16_t* o = (bf16_t*)(ws + OFF_WST) + (size_t)(tm * 256) * DM + tn * 256;
      EpiStoreBf16 e0{o, DM, nullptr}, e1{o + 128, DM, nullptr};
      gemm_tile2((const bf16_t*)(ws + OFF_SKBD) + (size_t)(tm * 256) * 256, 256,
                 (const bf16_t*)(ws + OFF_WQ) + (size_t)(tn * 256) * DM + tm * 256, DM, 256, shm, e0, e1);
    } else {
      const int tid = otid(), wid = tid >> 6, lane = tid & 63;
      const int row = (it - 64) * 16 + wid * 2;
      if (row < NTOK) { const int b = row >> 11; norm_mod_row2(p.x + (size_t)row * DM, p.g_norm1, mod + b * NMOD, mod + b * NMOD + DM, Hb + (size_t)row * DM, lane); }
      else { const int rc = row - NTOK; norm_mod_row2(p.ctx + (size_t)rc * DM, p.g_norm1, mod + 8 * NMOD, mod + 8 * NMOD + DM, HCb + (size_t)rc * DM, lane); }
    }
  }
  xcd_barrier(xb);

  REPS(2) for (int it = bid; it < 64 * 10 + 16 + 256; it += G) {
    if (it >= 64 * 10 + 16) {
      const int tid = otid(), wid = tid >> 6, lane = tid & 63, n = (it - (64 * 10 + 16)) * 8 + wid;
      const bf16_t* wr_ = (const bf16_t*)(ws + OFF_WST) + (size_t)n * DM + lane * 8;
      float wv[32];
#pragma unroll
      for (int i = 0; i < 4; ++i) { const u32x4 t = *(const u32x4*)(wr_ + i * 512);
#pragma unroll
        for (int q = 0; q < 4; ++q) { wv[i * 8 + 2 * q] = __uint_as_float(t[q] << 16); wv[i * 8 + 2 * q + 1] = __uint_as_float(t[q] & 0xffff0000u); } }
      for (int b = 0; b < 8; ++b) { const float* sh = mod + b * NMOD + 3 * DM + lane * 8; float s = 0.f;
#pragma unroll
        for (int i = 0; i < 4; ++i) { const f32x4 a = *(const f32x4*)(sh + i * 512), c = *(const f32x4*)(sh + i * 512 + 4);
          s += a[0] * wv[i * 8] + a[1] * wv[i * 8 + 1] + a[2] * wv[i * 8 + 2] + a[3] * wv[i * 8 + 3] + c[0] * wv[i * 8 + 4] + c[1] * wv[i * 8 + 5] + c[2] * wv[i * 8 + 6] + c[3] * wv[i * 8 + 7]; }
        s = wave_sum(s);
        if (lane == 0) ((float*)(ws + OFF_CVEC))[b * 2048 + n] = s; }
      continue;
    }
    EpiInProj e[2];
    const bool lat = it < 64 * 10;
    const int tn = lat ? it / 64 : (it - 64 * 10) & 1, tm = lat ? it % 64 : (it - 64 * 10) >> 1;
#pragma unroll
    for (int hb = 0; hb < 2; ++hb) {
      EpiInProj& ep = e[hb];
      ep = EpiInProj{};
      ep.gq = p.g_q; ep.gk = p.g_k; ep.rope = (const float*)(ws + OFF_ROPE);
      ep.Qb = (bf16_t*)(ws + OFF_Q); ep.Kb = (bf16_t*)(ws + OFF_K); ep.Vb = (bf16_t*)(ws + OFF_V); ep.PQt = (bf16_t*)(ws + OFF_PQT); ep.Fb = (bf16_t*)(ws + OFF_F);
      if (lat) {
        const int t1 = tn * 2 + hb;
        ep.b = tm >> 3; ep.l0 = (tm & 7) * 256; ep.isctx = 0; ep.row0 = tm * 256;
        if (t1 < 8) { ep.kind = 0; ep.head = t1; }
        else if (t1 < 10) { ep.kind = 1; ep.head = t1 - 8; }
        else if (t1 < 12) { ep.kind = 2; ep.head = t1 - 10; }
        else { ep.kind = 4; ep.fcol = (t1 - 12) * 128; }
      } else { ep.b = tm; ep.l0 = 0; ep.isctx = 1; ep.kind = tn == 0 ? 1 : 2; ep.head = hb; }
    }
    if (lat) gemm_tile2(Hb + (size_t)(tm * 256) * DM, DM, WinT + (size_t)(tn * 256) * DM, DM, DM, shm, e[0], e[1]);
    else     gemm_tile2(HCb + (size_t)(tm * 256) * DM, DM, WinT + (size_t)(1024 + tn * 256) * DM, DM, DM, shm, e[0], e[1]);
  }
  if (G == 256) {
    if (bid < 144) { for (int k = 0; k < 3; ++k) quant_item(p, bid * 3 + k); }
    else { for (int q = 432 + (bid - 144); q < 2048; q += 112) quant_item(p, q); }
  } else { for (int q = bid; q < 2048; q += G) quant_item(p, q); }
  xcd_barrier(xb);

  for (int it = bid; it < 512; it += G) {
    const int g = it >> 7, ab = (it >> 6) & 1, tm = it & 63;
    bf16_t* o = (bf16_t*)(ws + OFF_PQT) + ((size_t)(((tm >> 3) * 4 + g) * 256)) * 4096 + ab * 2048 + (tm & 7) * 256;
    EpiPQT e0{o}, e1{o + (size_t)128 * 4096};
    gemm_tile2<EpiPQT, true>((const bf16_t*)(ws + OFF_F) + (size_t)(tm * 256) * 1024 + g * 256, 1024,
               (const bf16_t*)(ws + OFF_ABT) + (size_t)(g * 512 + ab * 256) * 256, 256, 256, shm, e0, e1);
  }
  xcd_barrier(xb);

  {
    bf16_t* mix = (bf16_t*)(ws + OFF_MIX);
    const int xcd = bid & 7, jj = bid >> 3;
    REPS(3) for (int it = bid; it < 512; it += G) {
      int b, h, qb;
      if (G == 256) { const int rnd = it >> 8, pair = rnd * 8 + xcd; b = pair >> 1; h = (pair & 1) * 4 + (jj >> 3); qb = jj & 7; }
      else { b = it >> 6; h = (it >> 3) & 7; qb = it & 7; }
      const int kvh = h >> 2;
      attn::body((const bf16_t*)(ws + OFF_Q) + ((size_t)((b * 8 + h) * SEQ) + qb * 256) * 128,
                 (const bf16_t*)(ws + OFF_K) + (size_t)((b * 2 + kvh) * LK) * 128,
                 (const bf16_t*)(ws + OFF_V) + (size_t)((b * 2 + kvh) * LK) * 128,
                 mix + (size_t)(b * SEQ + qb * 256) * DM + h * 128, LK, shm);
    }
    float* UW = (float*)(ws + OFF_H);
    REPS(4) for (int it = bid; it < 256; it += G) {
      const int bg = it >> 3, uw = (it >> 2) & 1, tm = it & 3;
      float* o = UW + ((size_t)(uw * 32 + bg) * 1024 + tm * 256) * 256;
      EpiStoreF32 e0{o, 256}, e1{o + 128, 256};
      gemm_tile2((const bf16_t*)(ws + OFF_TTAB) + (size_t)(tm * 256) * 4096 + uw * 2048, 4096,
                 (const bf16_t*)(ws + OFF_PQT) + (size_t)(bg * 256) * 4096 + uw * 2048, 4096, 2048, shm, e0, e1);
    }
    xcd_barrier(xb);
    for (int it = bid; it < 4096 + 1024; it += G) {
      const int tid = otid(), wid = tid >> 6, lane = tid & 63;
      if (it < 4096) {
        const int row = it * 8 + wid, bg = row >> 10, k = row & 1023, b = bg >> 2, g = bg & 3, d = lane * 4;
        const f32x4 u = __builtin_nontemporal_load((const f32x4*)(UW + ((size_t)bg * 1024 + k) * 256 + d)), w = __builtin_nontemporal_load((const f32x4*)(UW + ((size_t)(32 + bg) * 1024 + k) * 256 + d));
        const f32x4 bs = *(const f32x4*)(p.b_fourier + g * 256 + d);
        bf16_t* o = mix + (size_t)(b * SEQ + k) * DM + 1024 + g * 256 + d;
        *(u32x2*)o = (u32x2){cvtpk(u[0] + w[0] + bs[0], u[1] + w[1] + bs[1]), cvtpk(u[2] + w[2] + bs[2], u[3] + w[3] + bs[3])};
        if (k > 0) { bf16_t* o2 = mix + (size_t)(b * SEQ + 2048 - k) * DM + 1024 + g * 256 + d;
          *(u32x2*)o2 = (u32x2){cvtpk(u[0] - w[0] + bs[0], u[1] - w[1] + bs[1]), cvtpk(u[2] - w[2] + bs[2], u[3] - w[3] + bs[3])}; }
      } else {
        const int q = (it - 4096) * 8 + wid, bg = q >> 8, d = q & 255, b = bg >> 2, g = bg & 3;
        const bf16_t* pr = (const bf16_t*)(ws + OFF_PQT) + (size_t)(bg * 256 + d) * 4096 + lane * 8;
        float s = 0.f;
#pragma unroll
        for (int i = 0; i < 4; ++i) { const u32x4 t = *(const u32x4*)(pr + i * 512);
#pragma unroll
          for (int e = 0; e < 4; ++e) s += __uint_as_float(t[e] << 16) - __uint_as_float(t[e] & 0xffff0000u); }
        s = wave_sum(s);
        if (lane == 0) mix[(size_t)(b * SEQ + 1024) * DM + 1024 + g * 256 + d] = f2bf(s + p.b_fourier[g * 256 + d]);
      }
    }
  }
  xcd_barrier(xb);

  REPS(5) for (int it = bid; it < 512; it += G) {
    const int tn = it >> 6, tm = it & 63, b = tm >> 3;
    const size_t o = (size_t)(tm * 256) * DM + tn * 256;
    const float* mb = mod + b * NMOD;
    EpiOutProj e0{p.x + o, mb + 2 * DM + tn * 256, p.out + o, p.g_norm2 + tn * 256, mb + 4 * DM + tn * 256, Hb + o, (float*)(ws + OFF_SSQ) + (size_t)(tm * 256) * 16 + tn * 2};
    EpiOutProj e1{p.x + o + 128, mb + 2 * DM + tn * 256 + 128, p.out + o + 128, p.g_norm2 + tn * 256 + 128, mb + 4 * DM + tn * 256 + 128, Hb + o + 128, (float*)(ws + OFF_SSQ) + (size_t)(tm * 256) * 16 + tn * 2 + 1};
    gemm_tile2((const bf16_t*)(ws + OFF_MIX) + (size_t)(tm * 256) * DM, DM, (const bf16_t*)(ws + OFF_WOUTT) + (size_t)(tn * 256) * DM, DM, DM, shm, e0, e1);
  }
  xcd_barrier(xb);

  REPS(7) for (int it = bid; it < 512; it += G) {
    const int tn = it >> 6, tm = it & 63;
    const float* cvb = (const float*)(ws + OFF_CVEC) + (tm >> 3) * 2048 + tn * 256;
    EpiTopk e0{(unsigned*)(ws + OFF_TOPK), tm * 256, tn * 2, (const float*)(ws + OFF_SSQ), cvb}, e1{(unsigned*)(ws + OFF_TOPK), tm * 256, tn * 2 + 1, (const float*)(ws + OFF_SSQ), cvb + 128};
    gemm_tile2(Hb + (size_t)(tm * 256) * DM, DM, (const bf16_t*)(ws + OFF_WST) + (size_t)(tn * 256) * DM, DM, DM, shm, e0, e1);
  }
  xcd_barrier(xb);

  if ((REPK) == 9) { for (int i_ = 0; i_ < 10; ++i_) xcd_barrier(xb); }
  {
    const int tid = otid(), wid = tid >> 6, lane = tid & 63;
    char* wl = shm + wid * 12800;
    for (int it0 = bid; it0 < 2048; it0 += 8 * G) {
      const int rem = (2048 - it0 + G - 1) / G, ntok = rem < 8 ? rem : 8;
      peer_wave8(p, it0 * 8 + wid, G * 8, ntok, wl, lane);
    }
  }
}

extern "C" void kernel_launch(void* const* d_in, const int* in_sizes, int n_in,
                              void* d_out, int out_size, void* d_ws, size_t ws_size,
                              hipStream_t stream) {
  static int grid_blocks = 0;
  if (!grid_blocks) {
    int dev = 0, cus = 0, per_cu = 0;
    (void)hipGetDevice(&dev);
    (void)hipDeviceGetAttribute(&cus, hipDeviceAttributeMultiprocessorCount, dev);
    (void)hipFuncSetAttribute((const void*)mega, hipFuncAttributeMaxDynamicSharedMemorySize, (int)DYN_LDS);
    (void)hipOccupancyMaxActiveBlocksPerMultiprocessor(&per_cu, mega, NT, DYN_LDS);
    if (per_cu < 1) per_cu = 1;
    grid_blocks = cus * per_cu;
    if (ws_size < WS_END) fprintf(stderr, "workspace too small: %zu < %zu\n", ws_size, (size_t)WS_END);
  }
  Params p{};
  const float** pp = (const float**)&p;
  for (int i = 0; i < 19; ++i) pp[i] = (const float*)d_in[i];
  p.out = (float*)d_out; p.ws = (char*)d_ws;
  (void)hipMemsetAsync((char*)d_ws + OFF_BAR, 0, 16384, stream);
  void* args[] = {&p};
  hipError_t e = hipLaunchCooperativeKernel((void*)mega, dim3(grid_blocks), dim3(NT), args, DYN_LDS, stream);
  if (e != hipSuccess) fprintf(stderr, "cooperative launch failed: %s (grid %d)\n", hipGetErrorString(e), grid_blocks);
}
```

```cpp
#include <hip/hip_runtime.h>
#include <hip/hip_bf16.h>
#include <hip/hip_cooperative_groups.h>
#include <cstdio>
#include <cstdint>
namespace cg = cooperative_groups;

typedef unsigned short bf16_t;
using bf16x8 = __attribute__((ext_vector_type(8))) short;
using s16x4  = __attribute__((ext_vector_type(4))) short;
using f32x4  = __attribute__((ext_vector_type(4))) float;
using f32x16 = __attribute__((ext_vector_type(16))) float;
using u32x4  = __attribute__((ext_vector_type(4))) unsigned;
using u32x2  = __attribute__((ext_vector_type(2))) unsigned;
typedef float f2_t __attribute__((ext_vector_type(2)));

constexpr int DM = 2048, NB = 8, SEQ = 2048, NTOK = NB * SEQ, CTX = 256, LK = SEQ + CTX;
constexpr int NMOD = 6 * DM;
constexpr int NIN = 2560;
constexpr int NT = 512;
constexpr int NEXP = 16384;
constexpr float EPS = 1e-6f;
constexpr size_t DYN_LDS = 140 * 1024;
#ifndef REPK
#define REPK -1
#endif
#define REPS(k) for (int rep_ = 0; rep_ < ((REPK) == (k) ? 2 : 1); ++rep_)

constexpr size_t al256(size_t x) { return (x + 255) / 256 * 256; }
constexpr size_t OFF_MOD   = 0;
constexpr size_t OFF_ROPE  = OFF_MOD   + al256((size_t)9 * NMOD * 4);
constexpr size_t OFF_WINT  = OFF_ROPE  + al256((size_t)64 * 32 * 2 * 4);
constexpr size_t OFF_WFIN  = OFF_WINT  + al256((size_t)NIN * DM * 2);
constexpr size_t OFF_ABT   = OFF_WFIN  + al256((size_t)DM * 1024 * 2);
constexpr size_t OFF_WOUTT = OFF_ABT   + al256((size_t)4 * 512 * 256 * 2);
constexpr size_t OFF_WQ    = OFF_WOUTT + al256((size_t)DM * DM * 2);
constexpr size_t OFF_SKBD  = OFF_WQ    + al256((size_t)DM * DM * 2);
constexpr size_t OFF_WST   = OFF_SKBD  + al256((size_t)2048 * 256 * 2);
constexpr size_t OFF_TTAB  = OFF_WST   + al256((size_t)DM * DM * 2);
constexpr size_t OFF_H     = OFF_TTAB  + al256((size_t)2048 * 4096 * 2);
constexpr size_t OFF_HC    = OFF_H     + al256((size_t)NTOK * DM * 2);
constexpr size_t OFF_Q     = OFF_HC    + al256((size_t)NB * CTX * DM * 2);
constexpr size_t OFF_K     = OFF_Q     + al256((size_t)NB * 8 * SEQ * 128 * 2);
constexpr size_t OFF_V     = OFF_K     + al256((size_t)NB * 2 * LK * 128 * 2);
constexpr size_t OFF_PQT   = OFF_V     + al256((size_t)NB * 2 * LK * 128 * 2);
constexpr size_t OFF_MIX   = OFF_PQT   + al256((size_t)NB * 4 * 256 * 4096 * 2);
constexpr size_t OFF_TOPK  = OFF_MIX   + al256((size_t)NTOK * DM * 2);
constexpr size_t OFF_UQ    = OFF_TOPK  + al256((size_t)NTOK * 256 * 4);
constexpr size_t OFF_VQ    = OFF_UQ    + al256((size_t)NEXP * DM);
constexpr size_t OFF_US    = OFF_VQ    + al256((size_t)NEXP * DM);
constexpr size_t OFF_VS    = OFF_US    + al256((size_t)NEXP * 4);
constexpr size_t OFF_F     = OFF_VS    + al256((size_t)NEXP * 4);
constexpr size_t OFF_SSQ   = OFF_F     + al256((size_t)NTOK * 1024 * 2);
constexpr size_t OFF_CVEC  = OFF_SSQ   + al256((size_t)NTOK * 16 * 4);
constexpr size_t OFF_USUM  = OFF_CVEC  + al256((size_t)8 * 2048 * 4);
constexpr size_t OFF_BAR   = OFF_USUM  + al256((size_t)NEXP * 4);
constexpr size_t WS_END    = OFF_BAR   + 16384;

struct Params {
  const float *x, *c, *ctx, *c_ctx, *w_ada, *b_ada, *g_norm1, *w_in, *g_q, *g_k, *w_fourier, *b_fourier,
              *w_out, *g_norm2, *w_query, *sub_keys, *u_exp, *v_exp, *g_final;
  float* out; char* ws;
};

__device__ __forceinline__ int otid() { int t = threadIdx.x; asm volatile("" : "+v"(t)); return t; }
template <int CTRL> __device__ __forceinline__ float dpp_f(float v) { return __int_as_float(__builtin_amdgcn_update_dpp(0, __float_as_int(v), CTRL, 0xf, 0xf, false)); }
template <int CTRL> __device__ __forceinline__ int dpp_i(int v) { return __builtin_amdgcn_update_dpp(0, v, CTRL, 0xf, 0xf, false); }
__device__ __forceinline__ float xor1_f(float v) { return dpp_f<0xB1>(v); }
__device__ __forceinline__ float xor2_f(float v) { return dpp_f<0x4E>(v); }
__device__ __forceinline__ int xor1_i(int v) { return dpp_i<0xB1>(v); }
__device__ __forceinline__ int xor2_i(int v) { return dpp_i<0x4E>(v); }
__device__ __forceinline__ float wave_sum(float v) {
  v += dpp_f<0xB1>(v); v += dpp_f<0x4E>(v); v += dpp_f<0x141>(v); v += dpp_f<0x140>(v);
  { auto rr = __builtin_amdgcn_permlane16_swap(__float_as_uint(v), __float_as_uint(v), false, false); v = __uint_as_float(rr[0]) + __uint_as_float(rr[1]); }
  { auto rr = __builtin_amdgcn_permlane32_swap(__float_as_uint(v), __float_as_uint(v), false, false); v = __uint_as_float(rr[0]) + __uint_as_float(rr[1]); }
  return v;
}
__device__ __forceinline__ int wave_sum_i(int v) {
  v += dpp_i<0xB1>(v); v += dpp_i<0x4E>(v); v += dpp_i<0x141>(v); v += dpp_i<0x140>(v);
  { auto rr = __builtin_amdgcn_permlane16_swap((unsigned)v, (unsigned)v, false, false); v = (int)rr[0] + (int)rr[1]; }
  { auto rr = __builtin_amdgcn_permlane32_swap((unsigned)v, (unsigned)v, false, false); v = (int)rr[0] + (int)rr[1]; }
  return v;
}
__device__ __forceinline__ float wave_max(float v) {
  v = fmaxf(v, dpp_f<0xB1>(v)); v = fmaxf(v, dpp_f<0x4E>(v)); v = fmaxf(v, dpp_f<0x141>(v)); v = fmaxf(v, dpp_f<0x140>(v));
  { auto rr = __builtin_amdgcn_permlane16_swap(__float_as_uint(v), __float_as_uint(v), false, false); v = fmaxf(__uint_as_float(rr[0]), __uint_as_float(rr[1])); }
  { auto rr = __builtin_amdgcn_permlane32_swap(__float_as_uint(v), __float_as_uint(v), false, false); v = fmaxf(__uint_as_float(rr[0]), __uint_as_float(rr[1])); }
  return v;
}
__device__ __forceinline__ unsigned cvtpk(float lo, float hi) {
  unsigned r; asm volatile("v_cvt_pk_bf16_f32 %0, %1, %2" : "=v"(r) : "v"(lo), "v"(hi)); return r;
}
__device__ __forceinline__ bf16_t f2bf(float f) { return (bf16_t)(cvtpk(f, 0.f) & 0xffffu); }
__device__ __forceinline__ void fmix_lo(float& acc, float w, unsigned h) { asm("v_fma_mix_f32 %0, %1, %2, %0 op_sel:[0,0,0] op_sel_hi:[0,1,0]" : "+v"(acc) : "v"(w), "v"(h)); }
__device__ __forceinline__ void fmix_hi(float& acc, float w, unsigned h) { asm("v_fma_mix_f32 %0, %1, %2, %0 op_sel:[0,1,0] op_sel_hi:[0,1,0]" : "+v"(acc) : "v"(w), "v"(h)); }
__device__ __forceinline__ unsigned and_or(unsigned x, unsigned m, unsigned o) { unsigned r; asm("v_and_or_b32 %0, %1, %2, %3" : "=v"(r) : "v"(x), "s"(m), "v"(o)); return r; }
__device__ __forceinline__ float silu(float v) { return v / (1.f + __expf(-v)); }

#define LAS __attribute__((address_space(3)))
#define XB_TMO      128
#define XB_XCNT(j)  (256  + 64 * (j))
#define XB_XSUB(j)  (1280 + 64 * (j))
#define XB_XGEN(j)  (2304 + 64 * (j))
#define XB_TOP      3328
#define XB_TOPGEN   3392
#define XCD_BAR_WORDS 3456
#define XB_SPIN_CAP (1u << 18)

__device__ __forceinline__ unsigned xb_ld(unsigned* p)              { return __hip_atomic_load(p, __ATOMIC_RELAXED, __HIP_MEMORY_SCOPE_AGENT); }
__device__ __forceinline__ unsigned xb_add(unsigned* p, unsigned v) { return __hip_atomic_fetch_add(p, v, __ATOMIC_RELAXED, __HIP_MEMORY_SCOPE_AGENT); }
__device__ __forceinline__ unsigned xb_xcc_id() { return (unsigned)__builtin_amdgcn_s_getreg((3 << 11) | 20) & 0xFu; }
#define XB_SPIN(cond, bar) do { unsigned _sp = 0; while (cond) { __builtin_amdgcn_s_sleep(1); \
    if ((++_sp & 255u) == 0u) { if (xb_ld(&(bar)[XB_TMO])) break; if (_sp > XB_SPIN_CAP) { atomicAdd(&(bar)[XB_TMO], 1u); break; } } } } while (0)

struct XcdBarrier {
    unsigned* bar; unsigned x;
    volatile LAS unsigned* st;
};

__device__ __forceinline__ XcdBarrier xcd_barrier_post(unsigned* bar, volatile LAS unsigned* st) {
    XcdBarrier b; b.bar = bar; b.x = xb_xcc_id(); b.st = st;
    if (threadIdx.x == 0) (void)xb_add(&bar[XB_XCNT(b.x)], 1u);
    return b;
}
__device__ __forceinline__ void xcd_barrier_complete(unsigned* bar, unsigned x, unsigned& nloc, unsigned& nx) {
    const unsigned G = gridDim.x * gridDim.y * gridDim.z;
    unsigned sum, cnt, mine, sp = 0u;
    for (;;) {
        sum = 0u; cnt = 0u; mine = 0u;
#pragma unroll
        for (unsigned j = 0; j < 16; ++j) { const unsigned c = xb_ld(&bar[XB_XCNT(j)]); sum += c; cnt += (c > 0u) ? 1u : 0u; mine = (j == x) ? c : mine; }
        if (sum == G) break;
        __builtin_amdgcn_s_sleep(1);
        if ((++sp & 255u) == 0u) { if (xb_ld(&bar[XB_TMO])) break; if (sp > XB_SPIN_CAP) { atomicAdd(&bar[XB_TMO], 1u); break; } }
    }
    nloc = mine > 0u ? mine : 1u; nx = cnt > 0u ? cnt : 1u;
}

__device__ __forceinline__ void xcd_barrier(const XcdBarrier& b) {
    asm volatile("s_waitcnt vmcnt(0)" ::: "memory");
    __syncthreads();
    if (threadIdx.x == 0) {
        unsigned* bar = b.bar;
        __builtin_amdgcn_s_waitcnt(0);
        unsigned nloc = b.st[0], nx = b.st[1];
        if (nloc == 0u) { xcd_barrier_complete(bar, b.x, nloc, nx); b.st[0] = nloc; b.st[1] = nx; }
        const unsigned old = xb_add(&bar[XB_XSUB(b.x)], 1u);
        const unsigned gen = old / nloc;
        if (old + 1u == (gen + 1u) * nloc) {
            __builtin_amdgcn_fence(__ATOMIC_RELEASE, "agent");
            asm volatile("s_waitcnt vmcnt(0)" ::: "memory");
            const unsigned og = xb_add(&bar[XB_TOP], 1u);
            const unsigned tg = og / nx;
            if (og + 1u == (tg + 1u) * nx) xb_add(&bar[XB_TOPGEN], 1u);
            else XB_SPIN(xb_ld(&bar[XB_TOPGEN]) == tg, bar);
            __builtin_amdgcn_fence(__ATOMIC_ACQUIRE, "agent");
            xb_add(&bar[XB_XGEN(b.x)], 1u);
            asm volatile("s_waitcnt vmcnt(0)" ::: "memory");
        } else {
            XB_SPIN(xb_ld(&bar[XB_XGEN(b.x)]) == gen, bar);
            __builtin_amdgcn_fence(__ATOMIC_ACQUIRE, "agent");
            asm volatile("s_waitcnt vmcnt(0)" ::: "memory");
        }
    }
    __syncthreads();
}


__device__ __forceinline__ void gsync(unsigned* bar, unsigned& target) {
  asm volatile("s_waitcnt vmcnt(0) lgkmcnt(0)" ::: "memory");
  __syncthreads();
  if (threadIdx.x == 0) {
    target += gridDim.x;
    __builtin_amdgcn_fence(__ATOMIC_RELEASE, "agent");
    asm volatile("s_waitcnt vmcnt(0)" ::: "memory");
    __hip_atomic_fetch_add(bar, 1u, __ATOMIC_RELAXED, __HIP_MEMORY_SCOPE_AGENT);
    while (__hip_atomic_load(bar, __ATOMIC_RELAXED, __HIP_MEMORY_SCOPE_AGENT) < target) __builtin_amdgcn_s_sleep(1);
    __builtin_amdgcn_fence(__ATOMIC_ACQUIRE, "agent");
    asm volatile("s_waitcnt vmcnt(0)" ::: "memory");
  }
  __syncthreads();
}

constexpr int STG_LD = 136;
__device__ __forceinline__ int stg_idx(int r, int c) { return r * STG_LD + c + 4 * (c >> 6); }

template <class Epi, bool TS = false>
__device__ __forceinline__ void gemm_tile2(const bf16_t* __restrict__ A, int lda, const bf16_t* __restrict__ Bt, int ldb, int K,
                                           char* shm, const Epi& epi0, const Epi& epi1) {
  const int tid = otid(), wid = tid >> 6, lane = tid & 63, wr = wid >> 1, wc = wid & 1, fr = lane & 15, fq = lane >> 4;
  f32x4 acc[4][8];
#pragma unroll
  for (int m = 0; m < 4; ++m)
#pragma unroll
    for (int n = 0; n < 8; ++n) acc[m][n] = (f32x4){0.f, 0.f, 0.f, 0.f};
  const int srow = tid >> 3, sp = tid & 7, gch = sp ^ (srow & 7);
  const bf16_t* ga = A + (size_t)srow * lda + gch * 8;
  const bf16_t* gb = Bt + (size_t)srow * ldb + gch * 8;
  LAS char* l3 = (LAS char*)shm;
  LAS char* sA = l3; LAS char* sB = l3 + 65536;
  const int loff = tid * 16;
#define GLDS(buf, k0) do { \
    _Pragma("unroll") for (int j = 0; j < 4; ++j) { \
      __builtin_amdgcn_global_load_lds((const unsigned*)(ga + (size_t)(64 * j) * lda + (k0)), (LAS unsigned*)(sA + (buf) * 32768 + j * 8192 + loff), 16, 0, 0); \
      __builtin_amdgcn_global_load_lds((const unsigned*)(gb + (size_t)(64 * j) * ldb + (k0)), (LAS unsigned*)(sB + (buf) * 32768 + j * 8192 + loff), 16, 0, 0); } } while (0)
  __syncthreads();
  GLDS(0, 0);
  asm volatile("s_waitcnt vmcnt(0)" ::: "memory");
  __syncthreads();
  const int nk = K >> 6;
  const int aoff = (wr * 64 + fr) * 128, boff = (wc * 64 + fr) * 128, sw = fr & 7;
  for (int kt = 0; kt < nk; ++kt) {
    const int buf = kt & 1;
    if (kt + 1 < nk) GLDS(buf ^ 1, (kt + 1) << 6);
    const char* cA = shm + buf * 32768 + aoff; const char* cB = shm + 65536 + buf * 32768 + boff;
#pragma unroll
    for (int ks = 0; ks < 2; ++ks) {
      const int co = ((ks * 4 + fq) ^ sw) << 4;
      bf16x8 af[4], bfr[8];
#pragma unroll
      for (int m = 0; m < 4; ++m) af[m] = *(const bf16x8*)(cA + m * 2048 + co);
#pragma unroll
      for (int n = 0; n < 8; ++n) bfr[n] = *(const bf16x8*)(cB + (n >> 2) * 16384 + (n & 3) * 2048 + co);
#pragma unroll
      for (int m = 0; m < 4; ++m)
#pragma unroll
        for (int n = 0; n < 8; ++n) acc[m][n] = __builtin_amdgcn_mfma_f32_16x16x32_bf16(af[m], bfr[n], acc[m][n], 0, 0, 0);
    }
    asm volatile("s_waitcnt vmcnt(0)" ::: "memory");
    __syncthreads();
  }
#undef GLDS
  float* stg = (float*)shm;
#pragma unroll
  for (int hb = 0; hb < 2; ++hb) {
    if (hb) __syncthreads();
    if constexpr (TS) {
#pragma unroll
      for (int m = 0; m < 4; ++m)
#pragma unroll
        for (int n = 0; n < 4; ++n)
          *(f32x4*)(stg + (wc * 64 + n * 16 + fr) * 260 + wr * 64 + m * 16 + fq * 4) = acc[m][hb * 4 + n];
    } else {
#pragma unroll
    for (int m = 0; m < 4; ++m)
#pragma unroll
      for (int n = 0; n < 4; ++n)
#pragma unroll
        for (int j = 0; j < 4; ++j)
          stg[(wr * 64 + m * 16 + fq * 4 + j) * STG_LD + wc * 68 + n * 16 + fr] = acc[m][hb * 4 + n][j];
    }
    __syncthreads();
    if (hb == 0) epi0(stg); else epi1(stg);
  }
}

__device__ __forceinline__ void ld64(const float* stg, int r, int hf, float (&v)[64]) {
  const float* p = stg + r * STG_LD + hf * 68;
#pragma unroll
  for (int j = 0; j < 16; ++j) { f32x4 t = *(const f32x4*)(p + 4 * j); v[4 * j] = t[0]; v[4 * j + 1] = t[1]; v[4 * j + 2] = t[2]; v[4 * j + 3] = t[3]; }
}
__device__ __forceinline__ void st64bf(bf16_t* dst, const float (&v)[64]) {
#pragma unroll
  for (int j = 0; j < 8; ++j) {
    u32x4 w = {cvtpk(v[8 * j], v[8 * j + 1]), cvtpk(v[8 * j + 2], v[8 * j + 3]), cvtpk(v[8 * j + 4], v[8 * j + 5]), cvtpk(v[8 * j + 6], v[8 * j + 7])};
    *(u32x4*)(dst + 8 * j) = w;
  }
}

struct EpiStoreBf16 {
  bf16_t* dst; int ld; const float* bias;
  __device__ __forceinline__ void operator()(const float* stg) const {
    const int tid_ = otid(); const int r = tid_ >> 1, hf = tid_ & 1;
    float v[64]; ld64(stg, r, hf, v);
    if (bias) {
#pragma unroll
      for (int j = 0; j < 64; ++j) v[j] += bias[hf * 64 + j];
    }
    st64bf(dst + (size_t)r * ld + hf * 64, v);
  }
};

struct EpiStoreF32 {
  float* dst; int ld;
  __device__ __forceinline__ void operator()(const float* stg) const {
    const int tid_ = otid(); const int rr = tid_ >> 5, c4 = (tid_ & 31) * 4;
    const float* sp = stg + c4 + 4 * (c4 >> 6);
#pragma unroll 4
    for (int i = 0; i < 16; ++i) { const int r = rr + 16 * i; *(f32x4*)(dst + (size_t)r * ld + c4) = *(const f32x4*)(sp + r * STG_LD); }
  }
};

struct EpiPQT {
  bf16_t* dst;
  __device__ __forceinline__ void operator()(const float* stg) const {
    const int tid_ = otid(); const int dsel = tid_ >> 5, ch = tid_ & 31;
#pragma unroll
    for (int k = 0; k < 8; ++k) {
      const int d = dsel + 16 * k;
      const f32x4 a = *(const f32x4*)(stg + d * 260 + ch * 8), c = *(const f32x4*)(stg + d * 260 + ch * 8 + 4);
      *(u32x4*)(dst + (size_t)d * 4096 + ch * 8) = (u32x4){cvtpk(a[0], a[1]), cvtpk(a[2], a[3]), cvtpk(c[0], c[1]), cvtpk(c[2], c[3])};
    }
  }
};

struct EpiInProj {
  int kind;
  int b, l0;
  int isctx;
  int head;
  int g, ab, dh;
  const float* gq; const float* gk; const float* rope;
  bf16_t *Qb, *Kb, *Vb, *PQt, *Fb; int row0, fcol;
  __device__ __forceinline__ void operator()(const float* stg) const {
    const int tid = otid();
    if (kind == 3) {
      const int dcol = tid & 127, lq = tid >> 7;
      const int d = dh * 128 + dcol;
      bf16_t* dst = PQt + ((size_t)((b * 4 + g) * 256 + d)) * 4096 + ab * 2048 + l0;
      const float* p = stg + stg_idx(0, dcol);
#pragma unroll
      for (int ch = 0; ch < 8; ++ch) {
        const int lr = (lq * 8 + ch) * 8;
        float v[8];
#pragma unroll
        for (int jj = 0; jj < 8; ++jj) v[jj] = p[(lr + jj) * STG_LD];
        u32x4 w = {cvtpk(v[0], v[1]), cvtpk(v[2], v[3]), cvtpk(v[4], v[5]), cvtpk(v[6], v[7])};
        *(u32x4*)(dst + lr) = w;
      }
      return;
    }
    if (kind == 4 || kind == 2) {
      const int rr = tid >> 4, c8 = (tid & 15) * 8;
      bf16_t* base = kind == 4 ? Fb + (size_t)row0 * 1024 + fcol : Vb + ((size_t)((b * 2 + head) * LK) + (isctx ? SEQ : l0)) * 128;
      const int ldo = kind == 4 ? 1024 : 128;
      const float* sp = stg + c8 + 4 * (c8 >> 6);
#pragma unroll
      for (int i = 0; i < 8; ++i) { const int r = rr + 32 * i;
        const f32x4 x0 = *(const f32x4*)(sp + r * STG_LD), x1 = *(const f32x4*)(sp + r * STG_LD + 4);
        *(u32x4*)(base + (size_t)r * ldo + c8) = (u32x4){cvtpk(x0[0], x0[1]), cvtpk(x0[2], x0[3]), cvtpk(x1[0], x1[1]), cvtpk(x1[2], x1[3])}; }
      return;
    }
    const int r = tid >> 1, hf = tid & 1;
    float v[64]; ld64(stg, r, hf, v);
    if (kind == 2) {
      st64bf(Vb + ((size_t)((b * 2 + head) * LK) + (isctx ? SEQ : l0) + r) * 128 + hf * 64, v);
      return;
    }
    float ss = 0.f;
#pragma unroll
    for (int j = 0; j < 64; ++j) ss += v[j] * v[j];
    ss += xor1_f(ss);
    const float rs = rsqrtf(ss * (1.f / 128.f) + EPS);
    const float* gg = (kind == 0 ? gq : gk) + hf * 64;
#pragma unroll
    for (int j = 0; j < 64; ++j) v[j] = v[j] * rs * gg[j];
    if (!isctx) {
      const int l = l0 + r, pos = hf == 0 ? (l >> 6) : (l & 63);
      const float* rp = rope + pos * 64;
#pragma unroll
      for (int j = 0; j < 32; ++j) {
        const float cs = rp[2 * j], sn = rp[2 * j + 1], x1 = v[j], x2 = v[j + 32];
        v[j] = x1 * cs - x2 * sn; v[j + 32] = x2 * cs + x1 * sn;
      }
    }
    if (kind == 0) st64bf(Qb + ((size_t)((b * 8 + head) * SEQ) + l0 + r) * 128 + hf * 64, v);
    else           st64bf(Kb + ((size_t)((b * 2 + head) * LK) + (isctx ? SEQ : l0) + r) * 128 + hf * 64, v);
  }
};

struct EpiOutProj {
  const float* x; const float* gt1; float* xl;
  const float* g2; const float* sc2; bf16_t* a2; float* ssq;
  __device__ __forceinline__ void operator()(const float* stg) const {
    const int tid_ = otid(); const int rr = tid_ >> 5, c4 = (tid_ & 31) * 4;
    const f32x4 gv = *(const f32x4*)(gt1 + c4);
    const f32x4 gn = *(const f32x4*)(g2 + c4), sv = *(const f32x4*)(sc2 + c4);
    const f32x4 gs = {gn[0] * (1.f + sv[0]), gn[1] * (1.f + sv[1]), gn[2] * (1.f + sv[2]), gn[3] * (1.f + sv[3])};
    const float* sp = stg + c4 + 4 * (c4 >> 6);
#pragma unroll 4
    for (int i = 0; i < 16; ++i) {
      const int r = rr + 16 * i;
      const f32x4 a = *(const f32x4*)(sp + r * STG_LD), xv = __builtin_nontemporal_load((const f32x4*)(x + (size_t)r * DM + c4));
      f32x4 ov; ov[0] = xv[0] + gv[0] * a[0]; ov[1] = xv[1] + gv[1] * a[1]; ov[2] = xv[2] + gv[2] * a[2]; ov[3] = xv[3] + gv[3] * a[3];
      *(f32x4*)(xl + (size_t)r * DM + c4) = ov;
      *(u32x2*)(a2 + (size_t)r * DM + c4) = (u32x2){cvtpk(ov[0] * gs[0], ov[1] * gs[1]), cvtpk(ov[2] * gs[2], ov[3] * gs[3])};
      float s = ov[0] * ov[0] + ov[1] * ov[1] + ov[2] * ov[2] + ov[3] * ov[3];
      s += dpp_f<0xB1>(s); s += dpp_f<0x4E>(s); s += dpp_f<0x141>(s); s += dpp_f<0x140>(s);
      { auto q = __builtin_amdgcn_permlane16_swap(__float_as_uint(s), __float_as_uint(s), false, false); s = __uint_as_float(q[0]) + __uint_as_float(q[1]); }
      if ((tid_ & 31) == 0) ssq[(size_t)r * 16] = s;
    }
  }
};

#define CE(a, b) do { float _h = fmaxf(a, b), _l = fminf(a, b); a = _h; b = _l; } while (0)
struct EpiTopk {
  unsigned* topk; int row0, seg;
  const float* ssq; const float* cvec;
  __device__ __forceinline__ void operator()(const float* stg) const {
    const int tid_ = otid(); const int r = tid_ >> 1, hf = tid_ & 1;
    const float* p = stg + r * STG_LD + hf * 68;
    float rstd;
    { const float* sq = ssq + (size_t)(row0 + r) * 16; float s = 0.f;
#pragma unroll
      for (int j4 = 0; j4 < 4; ++j4) { const f32x4 t = *(const f32x4*)(sq + 4 * j4); s += t[0]; s += t[1]; s += t[2]; s += t[3]; }
      rstd = rsqrtf(s * (1.f / DM) + EPS); }
    const float* cv = cvec + hf * 64;
    float L[16];
#define BITONIC_MERGE16(X) do { \
    _Pragma("unroll") for (int i_ = 0; i_ < 8; ++i_) CE(X[i_], X[i_ + 8]); \
    _Pragma("unroll") for (int q_ = 0; q_ < 16; q_ += 8) { _Pragma("unroll") for (int i_ = 0; i_ < 4; ++i_) CE(X[q_ + i_], X[q_ + i_ + 4]); } \
    _Pragma("unroll") for (int q_ = 0; q_ < 16; q_ += 4) { _Pragma("unroll") for (int i_ = 0; i_ < 2; ++i_) CE(X[q_ + i_], X[q_ + i_ + 2]); } \
    _Pragma("unroll") for (int q_ = 0; q_ < 16; q_ += 2) CE(X[q_], X[q_ + 1]); } while (0)
#pragma unroll
    for (int ch = 0; ch < 4; ++ch) {
      float C[16];
#pragma unroll
      for (int j4 = 0; j4 < 4; ++j4) { const f32x4 t = *(const f32x4*)(p + ch * 16 + 4 * j4); const f32x4 cb = *(const f32x4*)(cv + ch * 16 + 4 * j4);
#pragma unroll
        for (int e = 0; e < 4; ++e) C[4 * j4 + e] = __uint_as_float((__float_as_uint(fmaf(t[e], rstd, cb[e])) & ~127u) | (unsigned)(hf * 64 + ch * 16 + j4 * 4 + e)); }
#pragma unroll
      for (int k = 2; k <= 16; k <<= 1)
#pragma unroll
        for (int j = k >> 1; j > 0; j >>= 1)
#pragma unroll
          for (int i = 0; i < 16; ++i) { const int l = i ^ j; if (l > i) { if ((i & k) == 0) CE(C[i], C[l]); else CE(C[l], C[i]); } }
      if (ch == 0) {
#pragma unroll
        for (int i = 0; i < 16; ++i) L[i] = C[i];
      } else {
#pragma unroll
        for (int i = 0; i < 16; ++i) L[i] = fmaxf(L[i], C[15 - i]);
        BITONIC_MERGE16(L);
      }
    }
    float M[16];
#pragma unroll
    for (int i = 0; i < 16; ++i) M[i] = fmaxf(L[i], xor1_f(L[15 - i]));
#pragma unroll
    for (int i = 0; i < 8; ++i) CE(M[i], M[i + 8]);
#pragma unroll
    for (int q = 0; q < 16; q += 8)
#pragma unroll
      for (int i = 0; i < 4; ++i) CE(M[q + i], M[q + i + 4]);
#pragma unroll
    for (int q = 0; q < 16; q += 4)
#pragma unroll
      for (int i = 0; i < 2; ++i) CE(M[q + i], M[q + i + 2]);
#pragma unroll
    for (int q = 0; q < 16; q += 2) CE(M[q], M[q + 1]);
    unsigned* dst = topk + ((size_t)(row0 + r) * 16 + seg) * 16 + hf * 8;
    u32x4 w0, w1;
    if (hf == 0) { w0 = (u32x4){__float_as_uint(M[0]), __float_as_uint(M[1]), __float_as_uint(M[2]), __float_as_uint(M[3])};
                   w1 = (u32x4){__float_as_uint(M[4]), __float_as_uint(M[5]), __float_as_uint(M[6]), __float_as_uint(M[7])}; }
    else         { w0 = (u32x4){__float_as_uint(M[8]), __float_as_uint(M[9]), __float_as_uint(M[10]), __float_as_uint(M[11])};
                   w1 = (u32x4){__float_as_uint(M[12]), __float_as_uint(M[13]), __float_as_uint(M[14]), __float_as_uint(M[15])}; }
    *(u32x4*)dst = w0; *(u32x4*)(dst + 4) = w1;
  }
};

namespace attn {
constexpr int D = 128, NW = 8, QBLK = 32, KVBLK = 64;
constexpr float SCALE = 0.088388347648318440f;
constexpr float THR = 8.f;
constexpr int LDQ = 128, LDK = 128, LDO = DM;
constexpr size_t SHM_V = KVBLK * D * 2, SHM_K = KVBLK * D * 2;
#define KSWZ(row, colB) ((row) * 256 + ((colB) ^ (((row) & 7) << 4)))
#define SBAR() __builtin_amdgcn_sched_barrier(0)
__device__ __forceinline__ int crow(int r, int hi) { return (r & 3) + 8 * (r >> 2) + 4 * hi; }
__device__ __forceinline__ void partialSM(f32x16& p0, f32x16& p1, float& m_reg, float& mn, float& alpha) {
  constexpr float C = SCALE * 1.4426950408889634f;
  float pmax = p0[0];
#pragma unroll
  for (int r = 1; r < 16; ++r) pmax = fmaxf(pmax, p0[r]);
#pragma unroll
  for (int r = 0; r < 16; ++r) pmax = fmaxf(pmax, p1[r]);
  { auto rr = __builtin_amdgcn_permlane32_swap(__float_as_uint(pmax), __float_as_uint(pmax), false, false);
    pmax = fmaxf(__uint_as_float(rr[0]), __uint_as_float(rr[1])); }
  if (__builtin_expect(__all(pmax - m_reg <= THR / SCALE), 1)) { mn = m_reg; alpha = 1.f; }
  else { mn = fmaxf(m_reg, pmax); alpha = __builtin_amdgcn_exp2f((m_reg - mn) * C); m_reg = mn; }
  float mnC = -mn * C;
#pragma unroll
  for (int r = 0; r < 16; ++r) p0[r] = fmaf(p0[r], C, mnC);
#pragma unroll
  for (int r = 0; r < 16; ++r) p1[r] = fmaf(p1[r], C, mnC);
#pragma unroll
  for (int r = 0; r < 16; ++r) p0[r] = __builtin_amdgcn_exp2f(p0[r]);
}
__device__ __forceinline__ void finishSM(f32x16& p0, f32x16& p1, float alpha, float& l_reg, bf16x8& pa0, bf16x8& pa1, bf16x8& pa2, bf16x8& pa3) {
#pragma unroll
  for (int r = 0; r < 16; ++r) p1[r] = __builtin_amdgcn_exp2f(p1[r]);
  float ps = 0;
#pragma unroll
  for (int r = 0; r < 16; ++r) ps += p0[r];
#pragma unroll
  for (int r = 0; r < 16; ++r) ps += p1[r];
  { auto rr = __builtin_amdgcn_permlane32_swap(__float_as_uint(ps), __float_as_uint(ps), false, false);
    ps = __uint_as_float(rr[0]) + __uint_as_float(rr[1]); }
  l_reg = l_reg * alpha + ps;
#define PK4(P, BASE, OUT) do { unsigned a0 = cvtpk(P[BASE + 0], P[BASE + 1]), a1 = cvtpk(P[BASE + 2], P[BASE + 3]);   \
    unsigned b0 = cvtpk(P[BASE + 4], P[BASE + 5]), b1 = cvtpk(P[BASE + 6], P[BASE + 7]);                              \
    auto r0 = __builtin_amdgcn_permlane32_swap(a0, b0, false, false); auto r1 = __builtin_amdgcn_permlane32_swap(a1, b1, false, false); \
    u32x4 w = {r0[0], r1[0], r0[1], r1[1]}; OUT = *reinterpret_cast<bf16x8*>(&w); } while (0)
  PK4(p0, 0, pa0); PK4(p0, 8, pa1); PK4(p1, 0, pa2); PK4(p1, 8, pa3);
#undef PK4
}
__device__ __forceinline__ void qkt(f32x16& p0, f32x16& p1, const char* Ks, const bf16x8* qr, int r32, int hi) {
  p0 = f32x16{}; p1 = f32x16{};
#pragma unroll
  for (int d0 = 0; d0 < 8; ++d0) { int cb = (d0 * 16 + hi * 8) * 2;
    bf16x8 b0 = *reinterpret_cast<const bf16x8*>(Ks + KSWZ(r32, cb));
    bf16x8 b1 = *reinterpret_cast<const bf16x8*>(Ks + KSWZ(32 + r32, cb));
    p0 = __builtin_amdgcn_mfma_f32_32x32x16_bf16(b0, qr[d0], p0, 0, 0, 0);
    p1 = __builtin_amdgcn_mfma_f32_32x32x16_bf16(b1, qr[d0], p1, 0, 0, 0); }
}
__device__ __forceinline__ int v_st(int k, int c) { const int kk = (k & ~0xC) | ((k & 4) << 1) | ((k & 8) >> 1); return ((kk >> 3) * 4 + (c >> 5)) * 512 + ((kk & 7) * 32 + (c & 31)) * 2; }
__device__ __forceinline__ int v_rd_base(int lane) { return ((lane & 3) << 3) | (((lane >> 2) & 3) << 6) | (((lane >> 4) & 1) << 5) | (((lane >> 5) & 1) << 8); }
constexpr int v_rd_off(int d0, int ks, int half) { return d0 * 512 + ks * 4096 + half * 2048; }
template <int OFF> __device__ __forceinline__ s16x4 tr_read(int vb) {
  s16x4 r; asm volatile("ds_read_b64_tr_b16 %0, %1 offset:%2" : "=&v"(r) : "v"(vb), "i"(OFF) : "memory"); return r;
}
template <int D0> __device__ __forceinline__ void pv_one(f32x16& od, int vb, bf16x8 pa0, bf16x8 pa1, bf16x8 pa2, bf16x8 pa3) {
  const s16x4 l0 = tr_read<v_rd_off(D0, 0, 0)>(vb), h0 = tr_read<v_rd_off(D0, 0, 1)>(vb), l1 = tr_read<v_rd_off(D0, 1, 0)>(vb), h1 = tr_read<v_rd_off(D0, 1, 1)>(vb);
  const s16x4 l2 = tr_read<v_rd_off(D0, 2, 0)>(vb), h2 = tr_read<v_rd_off(D0, 2, 1)>(vb), l3 = tr_read<v_rd_off(D0, 3, 0)>(vb), h3 = tr_read<v_rd_off(D0, 3, 1)>(vb);
  asm volatile("s_waitcnt lgkmcnt(0)" ::: "memory"); SBAR();
#define PK(L, H) (bf16x8){L[0], L[1], L[2], L[3], H[0], H[1], H[2], H[3]}
  od = __builtin_amdgcn_mfma_f32_32x32x16_bf16(pa0, PK(l0, h0), od, 0, 0, 0);
  od = __builtin_amdgcn_mfma_f32_32x32x16_bf16(pa1, PK(l1, h1), od, 0, 0, 0);
  od = __builtin_amdgcn_mfma_f32_32x32x16_bf16(pa2, PK(l2, h2), od, 0, 0, 0);
  od = __builtin_amdgcn_mfma_f32_32x32x16_bf16(pa3, PK(l3, h3), od, 0, 0, 0);
#undef PK
}
__device__ __forceinline__ void pv_d0(f32x16* o, int vb, bf16x8 pa0, bf16x8 pa1, bf16x8 pa2, bf16x8 pa3) {
  pv_one<0>(o[0], vb, pa0, pa1, pa2, pa3); pv_one<1>(o[1], vb, pa0, pa1, pa2, pa3); pv_one<2>(o[2], vb, pa0, pa1, pa2, pa3); pv_one<3>(o[3], vb, pa0, pa1, pa2, pa3);
}
__device__ __forceinline__ void body(const bf16_t* __restrict__ Qb, const bf16_t* __restrict__ Kh, const bf16_t* __restrict__ Vh,
                                     bf16_t* __restrict__ Ob, int seq, char* lds) {
  const int tid = otid(), wid = tid >> 6, lane = tid & 63, r32 = lane & 31, hi = lane >> 5;
  char* V_lds = lds; char* K_lds = lds + 2 * SHM_V;
  float* ws = (float*)(lds + 2 * SHM_V + 2 * SHM_K) + wid * 64; float* li_l = ws; float* al_l = ws + 32;
  float m_reg = -1e30f, l_reg = 0; f32x16 o[4] = {}; bf16x8 qr[8];
  const bf16_t* Qw = Qb + (long)(wid * QBLK + r32) * LDQ + hi * 8;
#pragma unroll
  for (int d0 = 0; d0 < 8; ++d0) qr[d0] = *(const bf16x8*)(Qw + d0 * 16);
  const int sr = tid >> 4, sc = (tid & 15) * 8, vst0 = v_st(sr, sc), vst1 = v_st(32 + sr, sc);
  const int vb0 = (int)(uintptr_t)V_lds + v_rd_base(lane);
  struct { bf16x8 vs0, vs1, ks0, ks1; } sr_[1];
#define SLOAD(i, k0) do { sr_[i].vs0 = *(const bf16x8*)(&Vh[(long)((k0) + sr) * LDK + sc]); sr_[i].vs1 = *(const bf16x8*)(&Vh[(long)((k0) + 32 + sr) * LDK + sc]); \
    sr_[i].ks0 = *(const bf16x8*)(&Kh[(long)((k0) + sr) * LDK + sc]); sr_[i].ks1 = *(const bf16x8*)(&Kh[(long)((k0) + 32 + sr) * LDK + sc]); } while (0)
#define SWRITE(b, i) do { *(bf16x8*)(V_lds + (b) * SHM_V + vst0) = sr_[i].vs0;          \
    *(bf16x8*)(V_lds + (b) * SHM_V + vst1) = sr_[i].vs1; int kc = sc * 2;               \
    *(bf16x8*)(K_lds + (b) * SHM_K + KSWZ(sr, kc)) = sr_[i].ks0;                       \
    *(bf16x8*)(K_lds + (b) * SHM_K + KSWZ(32 + sr, kc)) = sr_[i].ks1; } while (0)
#define SWAIT() asm volatile("s_waitcnt vmcnt(0)" ::: "memory")
#define RESC(a) do { if (__any((a) < 1.f)) { if (hi == 0) al_l[r32] = (a); asm volatile("s_waitcnt lgkmcnt(0)" ::: "memory"); \
    for (int d = 0; d < 4; ++d) for (int r = 0; r < 16; ++r) o[d][r] *= al_l[crow(r, hi)]; } } while (0)
  f32x16 pA0, pA1, pB0, pB1; float mnA, mnB, alA, alB; bf16x8 pa0, pa1, pa2, pa3; const int NTL = seq / KVBLK;
  constexpr int SE = 0, SO = 0;
  SLOAD(SE, 0); asm volatile("s_waitcnt vmcnt(0)" ::: "memory"); SWRITE(0, SE); __syncthreads();
  qkt(pA0, pA1, K_lds, qr, r32, hi); partialSM(pA0, pA1, m_reg, mnA, alA);
  SLOAD(SO, KVBLK);
  SWAIT(); SWRITE(1, SO); __syncthreads();
  for (int j = 1; j + 1 < NTL; j += 2) {
    SBAR(); qkt(pB0, pB1, K_lds + SHM_K, qr, r32, hi);
    finishSM(pA0, pA1, alA, l_reg, pa0, pa1, pa2, pa3); SBAR();
    SLOAD(SO, (j + 1) * KVBLK); SBAR();
    pv_d0(o, vb0, pa0, pa1, pa2, pa3); partialSM(pB0, pB1, m_reg, mnB, alB);
    __syncthreads(); SWAIT(); SWRITE(0, SE);
    RESC(alB); __syncthreads();
    SBAR(); qkt(pA0, pA1, K_lds, qr, r32, hi);
    finishSM(pB0, pB1, alB, l_reg, pa0, pa1, pa2, pa3); SBAR();
    SLOAD(SE, (j + 2) * KVBLK); SBAR();
    pv_d0(o, vb0 + (int)SHM_V, pa0, pa1, pa2, pa3); partialSM(pA0, pA1, m_reg, mnA, alA);
    __syncthreads(); SWAIT(); SWRITE(1, SO);
    RESC(alA); __syncthreads();
  }
  SBAR(); qkt(pB0, pB1, K_lds + SHM_K, qr, r32, hi);
  finishSM(pA0, pA1, alA, l_reg, pa0, pa1, pa2, pa3); SBAR();
  pv_d0(o, vb0, pa0, pa1, pa2, pa3); partialSM(pB0, pB1, m_reg, mnB, alB);
  __syncthreads(); RESC(alB);
  finishSM(pB0, pB1, alB, l_reg, pa0, pa1, pa2, pa3); SBAR();
  pv_d0(o, vb0 + (int)SHM_V, pa0, pa1, pa2, pa3);
  if (hi == 0) li_l[r32] = l_reg; asm volatile("s_waitcnt lgkmcnt(0)" ::: "memory");
  float rli[16];
#pragma unroll
  for (int r = 0; r < 16; ++r) rli[r] = __builtin_amdgcn_rcpf(li_l[crow(r, hi)]);
  bf16_t* Ow = Ob + (long)(wid * QBLK) * LDO;
#pragma unroll
  for (int r = 0; r < 16; ++r) { int orow = crow(r, hi);
#pragma unroll
    for (int d0 = 0; d0 < 4; ++d0) Ow[(long)orow * LDO + d0 * 32 + r32] = f2bf(o[d0][r] * rli[r]); }
#undef SLOAD
#undef SWRITE
#undef SWAIT
#undef RESC
  __syncthreads();
}
}

__device__ __forceinline__ void job_mod(const Params& p, int it, char* shm) {
  const int tid = otid(), w = tid >> 6, lane = tid & 63, rg = lane >> 4, cl = lane & 15;
  float* sc = (float*)shm;
  float* red = (float*)(shm + 73728);
  __syncthreads();
  for (int i = tid; i < 9 * 2048; i += NT) { int r = i >> 11, k = i & 2047; float v = r < 8 ? p.c[r * DM + k] : p.c_ctx[k]; sc[i] = silu(v); }
  __syncthreads();
  float a[9][4];
#pragma unroll
  for (int r = 0; r < 9; ++r)
#pragma unroll
    for (int q = 0; q < 4; ++q) a[r][q] = 0.f;
  const float* wp = p.w_ada + (size_t)(w * 256 + rg) * NMOD + it * 64 + cl * 4;
  const float* sp = sc + w * 256 + rg;
#pragma unroll 8
  for (int kk = 0; kk < 64; ++kk) {
    const f32x4 wv = __builtin_nontemporal_load((const f32x4*)(wp + (size_t)(kk * 4) * NMOD));
#pragma unroll
    for (int r = 0; r < 9; ++r) { const float s = sp[r * 2048 + kk * 4];
#pragma unroll
      for (int q = 0; q < 4; ++q) a[r][q] += s * wv[q]; }
  }
#pragma unroll
  for (int r = 0; r < 9; ++r)
#pragma unroll
    for (int q = 0; q < 4; ++q) { float v = a[r][q]; v += __shfl_xor(v, 16); v += __shfl_xor(v, 32); a[r][q] = v; }
  if (rg == 0) {
#pragma unroll
    for (int r = 0; r < 9; ++r) *(f32x4*)(red + (w * 9 + r) * 64 + cl * 4) = (f32x4){a[r][0], a[r][1], a[r][2], a[r][3]};
  }
  __syncthreads();
  float* mod = (float*)(p.ws + OFF_MOD);
  for (int o = tid; o < 576; o += NT) { const int r = o >> 6, cc = o & 63; float s = p.b_ada[it * 64 + cc];
#pragma unroll
    for (int ww = 0; ww < 8; ++ww) s += red[(ww * 9 + r) * 64 + cc];
    mod[r * NMOD + it * 64 + cc] = s; }
}
__device__ __forceinline__ void job_transpose(const float* src, int ld, int coff, bf16_t* dst, int ldd, int tr, int tc, char* shm) {
  float* s = (float*)shm;
  const int tid = otid();
  const int r = tid >> 3, c8 = (tid & 7) * 8;
  __syncthreads();
  { const float* g = src + (size_t)(tr * 64 + r) * ld + coff + tc * 64 + c8;
    const f32x4 a = __builtin_nontemporal_load((const f32x4*)g), b = __builtin_nontemporal_load((const f32x4*)(g + 4));
    float* sp = s + r * 65 + c8;
    sp[0] = a[0]; sp[1] = a[1]; sp[2] = a[2]; sp[3] = a[3]; sp[4] = b[0]; sp[5] = b[1]; sp[6] = b[2]; sp[7] = b[3]; }
  __syncthreads();
  { const int n = r, k8 = c8;
    const float* sp = s + k8 * 65 + n;
    const u32x4 w = {cvtpk(sp[0], sp[65]), cvtpk(sp[130], sp[195]), cvtpk(sp[260], sp[325]), cvtpk(sp[390], sp[455])};
    *(u32x4*)(dst + (size_t)(tc * 64 + n) * ldd + tr * 64 + k8) = w; }
}
__device__ __forceinline__ unsigned quant_pack8(const float* v, float inv, int off, int& qsum) {
  unsigned pk = 0;
#pragma unroll
  for (int b = 0; b < 4; ++b) {
    int lo = (int)floorf(v[b] * inv), hi = (int)floorf(v[4 + b] * inv);
    lo = max(-8, min(7, lo)); hi = max(-8, min(7, hi)); qsum += lo + hi; lo += off; hi += off;
    pk |= ((unsigned)lo & 15u) << (8 * b); pk |= ((unsigned)hi & 15u) << (8 * b + 4);
  }
  return pk;
}
__device__ __forceinline__ unsigned quant_pack8_fp4(const float* v, float inv) {
  unsigned pk = 0;
#pragma unroll
  for (int b = 0; b < 8; ++b) {
    const float y = v[b] * inv, a = fabsf(y);
    unsigned c = (a > 0.25f) + (a > 0.75f) + (a > 1.25f) + (a > 1.75f) + (a > 2.5f) + (a > 3.5f) + (a > 5.0f);
    c |= y < 0.f ? 8u : 0u;
    pk |= c << (b < 4 ? 8 * b : 8 * (b - 4) + 4);
  }
  return pk;
}
__device__ __forceinline__ void job_quant_rows2(const float* src, unsigned char* dstq, float* dsts, int* dsum, int row, int lane, int off) {
  const float* r = src + (size_t)row * DM;
  float v[2][32];
#pragma unroll
  for (int k = 0; k < 2; ++k)
#pragma unroll
    for (int i = 0; i < 8; ++i) { f32x4 t = __builtin_nontemporal_load((const f32x4*)(r + k * DM + i * 256 + lane * 4)); v[k][4 * i] = t[0]; v[k][4 * i + 1] = t[1]; v[k][4 * i + 2] = t[2]; v[k][4 * i + 3] = t[3]; }
  float ss[2] = {0.f, 0.f};
#pragma unroll
  for (int k = 0; k < 2; ++k)
#pragma unroll
    for (int j = 0; j < 32; ++j) ss[k] += v[k][j] * v[k][j];
  ss[0] = wave_sum(ss[0]); ss[1] = wave_sum(ss[1]);
#pragma unroll
  for (int k = 0; k < 2; ++k) {
    const float rms = sqrtf(ss[k] * (1.f / DM));
    const float step = rms > 0.f ? (off == 8 ? 0.48f : 0.3352f) * rms : 1.f, inv = 1.f / step;
    int qs = 0;
    u32x4 w;
    if (off == 8) w = (u32x4){quant_pack8_fp4(&v[k][0], inv), quant_pack8_fp4(&v[k][8], inv), quant_pack8_fp4(&v[k][16], inv), quant_pack8_fp4(&v[k][24], inv)};
    else w = (u32x4){quant_pack8(&v[k][0], inv, off, qs), quant_pack8(&v[k][8], inv, off, qs), quant_pack8(&v[k][16], inv, off, qs), quant_pack8(&v[k][24], inv, off, qs)};
    *(u32x4*)(dstq + (size_t)(row + k) * 1024 + lane * 16) = w;
    qs = wave_sum_i(qs);
    if (lane == 0) { dsts[row + k] = step; if (dsum) dsum[row + k] = qs; }
  }
}

constexpr int J0 = 0, J1 = J0 + 192, J2 = J1 + 1280, J3 = J2 + 1024, J4 = J3 + 0, J5 = J4 + 1024, J6 = J5 + 128, J7 = J6 + 256,
              J8 = J7 + 512, J9 = J8 + 1, JEND = J9;

__device__ void phase0(const Params& p, char* shm) {
  const int tid = otid(), wid = tid >> 6, lane = tid & 63;
  for (int it = blockIdx.x; it < JEND; it += gridDim.x) {
    if (it < J1) job_mod(p, it - J0, shm);
    else if (it < J2) { int t = it - J1; job_transpose(p.w_in, 2560, 0, (bf16_t*)(p.ws + OFF_WINT), DM, t / 40, t % 40, shm); }
    else if (it < J3) { int t = it - J2; job_transpose(p.w_out, DM, 0, (bf16_t*)(p.ws + OFF_WOUTT), DM, t / 32, t % 32, shm); }
    else if (it < J4) {
      int base = (it - J3) * 4096 + tid * 8; int j = base >> 10, c = base & 1023;
      const float* s = p.w_in + (size_t)j * 2560 + 1536 + c; f32x4 a = *(const f32x4*)s, b = *(const f32x4*)(s + 4);
      *(u32x4*)((bf16_t*)(p.ws + OFF_WFIN) + base) = (u32x4){cvtpk(a[0], a[1]), cvtpk(a[2], a[3]), cvtpk(b[0], b[1]), cvtpk(b[2], b[3])};
    } else if (it < J5) {
      int base = (it - J4) * 4096 + tid * 8; const float* s = p.w_query + base; f32x4 a = *(const f32x4*)s, b = *(const f32x4*)(s + 4);
      *(u32x4*)((bf16_t*)(p.ws + OFF_WQ) + base) = (u32x4){cvtpk(a[0], a[1]), cvtpk(a[2], a[3]), cvtpk(b[0], b[1]), cvtpk(b[2], b[3])};
    } else if (it < J6) {
      int base = (it - J5) * 4096 + tid * 8; int row = base >> 8, col = base & 255; int hp = row >> 7;
      u32x4 w = {0u, 0u, 0u, 0u};
      if ((col >> 7) == (hp & 1)) { const float* s = p.sub_keys + (size_t)row * 128 + (col & 127); f32x4 a = *(const f32x4*)s, b = *(const f32x4*)(s + 4);
        w = (u32x4){cvtpk(a[0], a[1]), cvtpk(a[2], a[3]), cvtpk(b[0], b[1]), cvtpk(b[2], b[3])}; }
      *(u32x4*)((bf16_t*)(p.ws + OFF_SKBD) + base) = w;
    } else if (it < J7) {
      const int t = it - J6; const int g = t >> 6, ab = (t >> 5) & 1, c = (t & 31) * 8 + wid;
      float* tb = (float*)shm;
      __syncthreads();
      if (tid < 256) { float ang = (float)tid * (1.f / 128.f); tb[tid] = ab ? sinpif(ang) : cospif(ang); }
      __syncthreads();
      const float* wf = p.w_fourier + (size_t)g * 65536 + lane * 4;
      f32x4 a4 = {0.f, 0.f, 0.f, 0.f};
#pragma unroll 16
      for (int m = 0; m < 256; ++m) { const f32x4 wv = *(const f32x4*)(wf + m * 256); const float tv = tb[(m * c) & 255];
        a4[0] += tv * wv[0]; a4[1] += tv * wv[1]; a4[2] += tv * wv[2]; a4[3] += tv * wv[3]; }
      bf16_t* o = (bf16_t*)(p.ws + OFF_ABT) + ((size_t)(g * 512 + ab * 256 + lane * 4)) * 256 + c;
#pragma unroll
      for (int q = 0; q < 4; ++q) o[q * 256] = f2bf(a4[q] * 0.0013810679320049757f);
    } else if (it < J8) {
      int base = (it - J7) * 16384 + tid * 8;
      for (int rep = 0; rep < 4; ++rep, base += 4096) {
        int k = base >> 12, cl = base & 4095; unsigned w[4];
#pragma unroll
        for (int e = 0; e < 4; ++e) { float v2[2];
#pragma unroll
          for (int q = 0; q < 2; ++q) { int col = cl + e * 2 + q; int l = col & 2047; float ang = (float)((k * l) & 2047) * (1.f / 1024.f); v2[q] = (col >> 11) ? -sinpif(ang) : cospif(ang); }
          w[e] = cvtpk(v2[0], v2[1]); }
        *(u32x4*)((bf16_t*)(p.ws + OFF_TTAB) + base) = (u32x4){w[0], w[1], w[2], w[3]};
      }
    } else if (it < J9) {
      float* rt = (float*)(p.ws + OFF_ROPE);
      for (int i = tid; i < 2048; i += NT) { int pos = i >> 5, j = i & 31; float inv = powf(10000.f, -(float)j / 32.f); float ang = (float)pos * inv; rt[2 * i] = cosf(ang); rt[2 * i + 1] = sinf(ang); }
    }
  }
}
__device__ __forceinline__ void quant_item(const Params& p, int q) {
  const int tid = otid(), wid = tid >> 6, lane = tid & 63;
  const int row = (q & 1023) * 16 + wid * 2;
  if (q < 1024) job_quant_rows2(p.u_exp, (unsigned char*)(p.ws + OFF_UQ), (float*)(p.ws + OFF_US), (int*)(p.ws + OFF_USUM), row, lane, 0);
  else          job_quant_rows2(p.v_exp, (unsigned char*)(p.ws + OFF_VQ), (float*)(p.ws + OFF_VS), nullptr, row, lane, 8);
}

__device__ __forceinline__ void norm_mod_row2(const float* xr, const float* g, const float* sh, const float* sc, bf16_t* dst, int lane) {
  float v[2][32];
#pragma unroll
  for (int k = 0; k < 2; ++k)
#pragma unroll
    for (int i = 0; i < 8; ++i) { f32x4 t = __builtin_nontemporal_load((const f32x4*)(xr + k * DM + i * 256 + lane * 4)); v[k][4 * i] = t[0]; v[k][4 * i + 1] = t[1]; v[k][4 * i + 2] = t[2]; v[k][4 * i + 3] = t[3]; }
  float ss0 = 0.f, ss1 = 0.f;
#pragma unroll
  for (int j = 0; j < 32; ++j) { ss0 += v[0][j] * v[0][j]; ss1 += v[1][j] * v[1][j]; }
  ss0 = wave_sum(ss0); ss1 = wave_sum(ss1);
  const float rs0 = rsqrtf(ss0 * (1.f / DM) + EPS), rs1 = rsqrtf(ss1 * (1.f / DM) + EPS);
#pragma unroll
  for (int i = 0; i < 8; ++i) {
    const int c = i * 256 + lane * 4;
    const f32x4 gv = *(const f32x4*)(g + c), sv = *(const f32x4*)(sh + c), cv = *(const f32x4*)(sc + c);
    float m[4];
#pragma unroll
    for (int q = 0; q < 4; ++q) m[q] = gv[q] * (1.f + cv[q]);
    *(u32x2*)(dst + c) = (u32x2){cvtpk(v[0][4 * i] * rs0 * m[0] + sv[0], v[0][4 * i + 1] * rs0 * m[1] + sv[1]), cvtpk(v[0][4 * i + 2] * rs0 * m[2] + sv[2], v[0][4 * i + 3] * rs0 * m[3] + sv[3])};
    *(u32x2*)(dst + DM + c) = (u32x2){cvtpk(v[1][4 * i] * rs1 * m[0] + sv[0], v[1][4 * i + 1] * rs1 * m[1] + sv[1]), cvtpk(v[1][4 * i + 2] * rs1 * m[2] + sv[2], v[1][4 * i + 3] * rs1 * m[3] + sv[3])};
  }
}

__device__ __forceinline__ void peer_wave8(const Params& p, int tbase, int tstride, int ntok, char* wlds, int lane) {
  unsigned* keys = (unsigned*)wlds; int* eidxU = (int*)(wlds + 1024); float* gateU = (float*)(wlds + 1536);
  float* cand = (float*)(wlds + 2048); float* tokf = (float*)(wlds + 2304);
  unsigned short* eidxS = (unsigned short*)(wlds + 2560); float* gw = (float*)(wlds + 4608); int* red = (int*)(wlds + 8704);
  const float* mod = (const float*)(p.ws + OFF_MOD);
  unsigned* H2Q = (unsigned*)(p.ws + OFF_F);
  const unsigned char* Uq = (const unsigned char*)(p.ws + OFF_UQ); const float* Us = (const float*)(p.ws + OFF_US);
  const unsigned char* Vq = (const unsigned char*)(p.ws + OFF_VQ); const float* Vs = (const float*)(p.ws + OFF_VS);
  int ci = 0, cj = 0;
  { int cnt = 0;
#pragma unroll
    for (int i = 0; i < 16; ++i) { const int nj = 16 / (i + 1); if (lane >= cnt) { ci = i; cj = lane - cnt; } cnt += nj; } }
  asm volatile("" : "+v"(ci), "+v"(cj));
  const bool valid = lane < 50;
  for (int ti = 0; ti < ntok; ++ti) {
    const int t = tbase + ti * tstride, b = t >> 11;
    const unsigned* tk = (const unsigned*)(p.ws + OFF_TOPK) + (size_t)t * 256;
#pragma unroll
    for (int i = 0; i < 4; ++i) keys[i * 64 + lane] = tk[i * 64 + lane];
    __builtin_amdgcn_s_waitcnt(0xc07f);
    for (int h = 0; h < 8; ++h) {
      unsigned k1 = keys[(2 * h) * 16 + ci], k2 = keys[(2 * h + 1) * 16 + cj];
      float sv = __uint_as_float(k1 & ~127u) + __uint_as_float(k2 & ~127u);
      sv = valid ? __uint_as_float((__float_as_uint(sv) & ~63u) | (unsigned)(63 - lane)) : -3.0e38f;
      cand[lane] = sv;
      __builtin_amdgcn_s_waitcnt(0xc07f);
      int rank = 0;
#pragma unroll
      for (int o4 = 0; o4 < 13; ++o4) { f32x4 ov = *(const f32x4*)(cand + o4 * 4);
#pragma unroll
        for (int q = 0; q < 4; ++q) rank += (ov[q] > sv) ? 1 : 0; }
      const float mx = wave_max(sv);
      const bool sel = valid && rank < 16;
      float e = sel ? __expf(sv - mx) : 0.f;
      float se = wave_sum(e);
      if (sel) { eidxU[h * 16 + rank] = (int)((k1 & 127u) * 128u + (k2 & 127u)); gateU[h * 16 + rank] = e / se; }
    }
    __builtin_amdgcn_s_waitcnt(0xc07f);
    {
      const int e0 = eidxU[lane], e1 = eidxU[64 + lane]; const float g0 = gateU[lane], g1 = gateU[64 + lane];
      const int b0 = e0 >> 11, b1 = e1 >> 11;
      int pos0 = 0, pos1 = 0, base = 0;
#pragma unroll
      for (int bk = 0; bk < 8; ++bk) {
        const unsigned long long m0 = __ballot(b0 == bk), m1 = __ballot(b1 == bk);
        const int c0 = __popcll(m0), c1 = __popcll(m1);
        const int r0 = __builtin_amdgcn_mbcnt_hi((unsigned)(m0 >> 32), __builtin_amdgcn_mbcnt_lo((unsigned)m0, 0u));
        const int r1 = __builtin_amdgcn_mbcnt_hi((unsigned)(m1 >> 32), __builtin_amdgcn_mbcnt_lo((unsigned)m1, 0u));
        if (b0 == bk) pos0 = base + r0;
        if (b1 == bk) pos1 = base + c0 + r1;
        base += c0 + c1;
      }
      eidxS[ti * 128 + pos0] = (unsigned short)e0; gw[ti * 128 + pos0] = g0;
      eidxS[ti * 128 + pos1] = (unsigned short)e1; gw[ti * 128 + pos1] = g1;
    }
    const float* xrow = p.out + (size_t)t * DM;
    float xv[32];
#pragma unroll
    for (int i = 0; i < 8; ++i) { f32x4 tt = *(const f32x4*)(xrow + i * 256 + lane * 4); xv[4 * i] = tt[0]; xv[4 * i + 1] = tt[1]; xv[4 * i + 2] = tt[2]; xv[4 * i + 3] = tt[3]; }
    float ss = 0.f;
#pragma unroll
    for (int j = 0; j < 32; ++j) ss += xv[j] * xv[j];
    ss = wave_sum(ss);
    const float rs = rsqrtf(ss * (1.f / DM) + EPS);
    const float* sh2 = mod + b * NMOD + 3 * DM; const float* sc2 = mod + b * NMOD + 4 * DM;
    float hss = 0.f;
#pragma unroll
    for (int i = 0; i < 8; ++i) { const int c = i * 256 + lane * 4;
      const f32x4 g2 = *(const f32x4*)(p.g_norm2 + c), s2 = *(const f32x4*)(sc2 + c), h2 = *(const f32x4*)(sh2 + c);
#pragma unroll
      for (int q = 0; q < 4; ++q) { float hh = xv[4 * i + q] * rs * g2[q] * (1.f + s2[q]) + h2[q]; xv[4 * i + q] = hh; hss += hh * hh; } }
    hss = wave_sum(hss);
    const float hrms = sqrtf(hss * (1.f / DM));
    const float hsc = hrms > 0.f ? 0.3352f * hrms : 1.f, hinv = 1.f / hsc;
    int hsum = 0;
    const u32x4 hq4 = {quant_pack8(&xv[0], hinv, 0, hsum), quant_pack8(&xv[8], hinv, 0, hsum), quant_pack8(&xv[16], hinv, 0, hsum), quant_pack8(&xv[24], hinv, 0, hsum)};
    hsum = wave_sum_i(hsum);
    *(u32x4*)(H2Q + ((size_t)t * 64 + lane) * 4) = hq4;
    if (lane == 0) { tokf[ti * 2] = hsc; tokf[ti * 2 + 1] = (float)hsum; }
  }
  asm volatile("s_waitcnt vmcnt(0) lgkmcnt(0)" ::: "memory");
  u32x4 rA[16], rB[16]; u32x4 qA0, qA1, qB0, qB1;
  const int* Usum = (const int*)(p.ws + OFF_USUM);
#define ULOAD(R, Q0, Q1, S) do { const int j_ = (S) / ntok, ti_ = (S) - j_ * ntok; const int t_ = tbase + ti_ * tstride; \
    Q0 = *(const u32x4*)(H2Q + ((size_t)t_ * 64 + lane) * 4); \
    _Pragma("unroll") for (int i = 0; i < 16; ++i) { const int e_ = eidxS[ti_ * 128 + j_ * 16 + i]; R[i] = *(const u32x4*)(Uq + (size_t)e_ * 1024 + lane * 16); } } while (0)
#define UCOMP(R, Q0, Q1, S) do { const int j_ = (S) / ntok, ti_ = (S) - j_ * ntok; \
    _Pragma("unroll") for (int i = 0; i < 16; ++i) { int d_ = 0; \
      _Pragma("unroll") for (int q = 0; q < 4; ++q) d_ = __builtin_amdgcn_sdot8((int)Q0[q], (int)R[i][q], d_, false); \
      red[i * 64 + lane] = d_; } \
    __builtin_amdgcn_s_waitcnt(0xc07f); \
    const int ee_ = lane >> 2, sub_ = lane & 3; const int* rp_ = red + ee_ * 64 + sub_ * 16; int dd_ = 0; \
    _Pragma("unroll") for (int q = 0; q < 4; ++q) { const u32x4 qq_ = *(const u32x4*)(rp_ + 4 * q); dd_ += (int)qq_[0] + (int)qq_[1] + (int)qq_[2] + (int)qq_[3]; } \
    dd_ += xor1_i(dd_); dd_ += xor2_i(dd_); \
    const int k_ = ti_ * 128 + j_ * 16 + ee_, e2_ = eidxS[k_]; \
    const float pre_ = ((float)dd_ + 0.5f * (float)Usum[e2_] + 0.5f * tokf[ti_ * 2 + 1] + 512.f) * tokf[ti_ * 2] * Us[e2_]; \
    const float a_ = 0.5f * pre_ * (1.f + erff(pre_ * 0.70710678118654752f)); \
    const float w_ = gw[k_] * a_ * Vs[e2_]; \
    __builtin_amdgcn_s_waitcnt(0xc07f); \
    if (sub_ == 0) gw[k_] = w_; } while (0)
  {
    const int S = 8 * ntok;
    ULOAD(rA, qA0, qA1, 0);
    for (int s = 0; s < S; s += 2) {
      ULOAD(rB, qB0, qB1, s + 1); SBAR();
      UCOMP(rA, qA0, qA1, s); SBAR();
      if (s + 2 < S) ULOAD(rA, qA0, qA1, s + 2);
      SBAR();
      UCOMP(rB, qB0, qB1, s + 1); SBAR();
    }
  }
#undef ULOAD
#undef UCOMP
  __builtin_amdgcn_s_waitcnt(0xc07f);
  int laneC = lane; asm volatile("" : "+v"(laneC));
#define VLOAD(R, TI, KB) do { _Pragma("unroll") for (int i = 0; i < 4; ++i) { const int e_ = eidxS[(TI) * 128 + (KB) * 4 + i]; R[i] = *(const u32x4*)(Vq + (size_t)e_ * 1024 + laneC * 16); } } while (0)
#define VCOMP(ACC, R, TI, KB) do { \
    _Pragma("unroll") for (int i = 0; i < 4; ++i) { const float w_ = gw[(TI) * 128 + (KB) * 4 + i]; const f2_t w2_ = {w_, w_}; \
      _Pragma("unroll") for (int q = 0; q < 4; ++q) { const unsigned x_ = R[i][q]; \
        ACC[4 * q + 0] = __builtin_elementwise_fma(__builtin_amdgcn_cvt_scalef32_pk_f32_fp4(x_, 1.0f, 0), w2_, ACC[4 * q + 0]); \
        ACC[4 * q + 1] = __builtin_elementwise_fma(__builtin_amdgcn_cvt_scalef32_pk_f32_fp4(x_, 1.0f, 1), w2_, ACC[4 * q + 1]); \
        ACC[4 * q + 2] = __builtin_elementwise_fma(__builtin_amdgcn_cvt_scalef32_pk_f32_fp4(x_, 1.0f, 2), w2_, ACC[4 * q + 2]); \
        ACC[4 * q + 3] = __builtin_elementwise_fma(__builtin_amdgcn_cvt_scalef32_pk_f32_fp4(x_, 1.0f, 3), w2_, ACC[4 * q + 3]); } } } while (0)
#define VFINAL(ACC, TI) do { const int t_ = tbase + (TI) * tstride, b_ = t_ >> 11; \
    float* xrow_ = p.out + (size_t)t_ * DM; const float* gt2_ = mod + b_ * NMOD + 5 * DM; float ss2_ = 0.f; \
    _Pragma("unroll") for (int i = 0; i < 8; ++i) { const int c = i * 256 + laneC * 4; const f32x4 g4 = *(const f32x4*)(gt2_ + c), x4 = __builtin_nontemporal_load((const f32x4*)(xrow_ + c)); \
      _Pragma("unroll") for (int q = 0; q < 4; ++q) { float y = x4[q] + g4[q] * ACC[4 * (i >> 1) + q][i & 1]; ACC[4 * (i >> 1) + q][i & 1] = y; ss2_ += y * y; } } \
    ss2_ = wave_sum(ss2_); const float rs2_ = rsqrtf(ss2_ * (1.f / DM) + EPS); \
    _Pragma("unroll") for (int i = 0; i < 8; ++i) { const int c = i * 256 + laneC * 4; const f32x4 gf = *(const f32x4*)(p.g_final + c); f32x4 ov; \
      ov[0] = ACC[4 * (i >> 1)][i & 1] * rs2_ * gf[0]; ov[1] = ACC[4 * (i >> 1) + 1][i & 1] * rs2_ * gf[1]; ov[2] = ACC[4 * (i >> 1) + 2][i & 1] * rs2_ * gf[2]; ov[3] = ACC[4 * (i >> 1) + 3][i & 1] * rs2_ * gf[3]; \
      __builtin_nontemporal_store(ov, (f32x4*)(xrow_ + c)); } } while (0)
  for (int pg = 0; pg < ntok; pg += 2) {
    const int tiA = pg, tiB = pg + 1 < ntok ? pg + 1 : pg;
    f2_t accA[16], accB[16];
#pragma unroll
    for (int j = 0; j < 16; ++j) { accA[j] = (f2_t){0.f, 0.f}; accB[j] = (f2_t){0.f, 0.f}; }
    VLOAD(rA, tiA, 0);
    for (int j = 0; j < 32; ++j) {
      VLOAD(rB, tiB, j); SBAR();
      VCOMP(accA, rA, tiA, j); SBAR();
      if (j + 1 < 32) VLOAD(rA, tiA, j + 1);
      SBAR();
      VCOMP(accB, rB, tiB, j); SBAR();
    }
    VFINAL(accA, tiA);
    if (pg + 1 < ntok) VFINAL(accB, tiB);
  }
#undef VFINAL
#undef VLOAD
#undef VCOMP
}

__global__ void __launch_bounds__(NT) mega(Params p) {
  cg::grid_group grid = cg::this_grid();
  extern __shared__ __attribute__((aligned(16))) char shm[];
  const int G = gridDim.x, bid = blockIdx.x;
  char* ws = p.ws;
  const float* mod = (const float*)(ws + OFF_MOD);
  bf16_t* WinT = (bf16_t*)(ws + OFF_WINT);
  bf16_t* Hb = (bf16_t*)(ws + OFF_H); bf16_t* HCb = (bf16_t*)(ws + OFF_HC);
  unsigned* gbar = (unsigned*)(ws + OFF_BAR); unsigned gtarget = 0; (void)gtarget;
  volatile LAS unsigned* xst = (volatile LAS unsigned*)(LAS char*)(shm + DYN_LDS - 16);
  if (threadIdx.x == 0) { xst[0] = 0u; xst[1] = 0u; }
  __syncthreads();
  const XcdBarrier xb = xcd_barrier_post(gbar, xst);

  REPS(0) phase0(p, shm);
  if (p.ws == nullptr) grid.sync();
  xcd_barrier(xb);

  REPS(1) for (int it = bid; it < 64 + 1152; it += G) {
    if (false) {
    } else if (it < 64) {
      const int t2 = it, tm = t2 >> 3, tn = t2 & 7;
      bf16_t* o = (bf16_t*)(ws + OFF_WST) + (size_t)(tm * 256) * DM + tn * 256;
      EpiStoreBf16 e0{o, DM, nullptr}, e1{o + 128, DM, nullptr};
      gemm_tile2((const bf16_t*)(ws + OFF_SKBD) + (size_t)(tm * 256) * 256, 256,
                 (const bf16_t*)(ws + OFF_WQ) + (size_t)(tn * 256) * DM + tm * 256, DM, 256, shm, e0, e1);
    } else {
      const int tid = otid(), wid = tid >> 6, lane = tid & 63;
      const int row = (it - 64) * 16 + wid * 2;
      if (row < NTOK) { const int b = row >> 11; norm_mod_row2(p.x + (size_t)row * DM, p.g_norm1, mod + b * NMOD, mod + b * NMOD + DM, Hb + (size_t)row * DM, lane); }
      else { const int rc = row - NTOK; norm_mod_row2(p.ctx + (size_t)rc * DM, p.g_norm1, mod + 8 * NMOD, mod + 8 * NMOD + DM, HCb + (size_t)rc * DM, lane); }
    }
  }
  xcd_barrier(xb);

  REPS(2) for (int it = bid; it < 64 * 10 + 16 + 256; it += G) {
    if (it >= 64 * 10 + 16) {
      const int tid = otid(), wid = tid >> 6, lane = tid & 63, n = (it - (64 * 10 + 16)) * 8 + wid;
      const bf16_t* wr_ = (const bf16_t*)(ws + OFF_WST) + (size_t)n * DM + lane * 8;
      float wv[32];
#pragma unroll
      for (int i = 0; i < 4; ++i) { const u32x4 t = *(const u32x4*)(wr_ + i * 512);
#pragma unroll
        for (int q = 0; q < 4; ++q) { wv[i * 8 + 2 * q] = __uint_as_float(t[q] << 16); wv[i * 8 + 2 * q + 1] = __uint_as_float(t[q] & 0xffff0000u); } }
      for (int b = 0; b < 8; ++b) { const float* sh = mod + b * NMOD + 3 * DM + lane * 8; float s = 0.f;
#pragma unroll
        for (int i = 0; i < 4; ++i) { const f32x4 a = *(const f32x4*)(sh + i * 512), c = *(const f32x4*)(sh + i * 512 + 4);
          s += a[0] * wv[i * 8] + a[1] * wv[i * 8 + 1] + a[2] * wv[i * 8 + 2] + a[3] * wv[i * 8 + 3] + c[0] * wv[i * 8 + 4] + c[1] * wv[i * 8 + 5] + c[2] * wv[i * 8 + 6] + c[3] * wv[i * 8 + 7]; }
        s = wave_sum(s);
        if (lane == 0) ((float*)(ws + OFF_CVEC))[b * 2048 + n] = s; }
      continue;
    }
    EpiInProj e[2];
    const bool lat = it < 64 * 10;
    const int tn = lat ? it / 64 : (it - 64 * 10) & 1, tm = lat ? it % 64 : (it - 64 * 10) >> 1;
#pragma unroll
    for (int hb = 0; hb < 2; ++hb) {
      EpiInProj& ep = e[hb];
      ep = EpiInProj{};
      ep.gq = p.g_q; ep.gk = p.g_k; ep.rope = (const float*)(ws + OFF_ROPE);
      ep.Qb = (bf16_t*)(ws + OFF_Q); ep.Kb = (bf16_t*)(ws + OFF_K); ep.Vb = (bf16_t*)(ws + OFF_V); ep.PQt = (bf16_t*)(ws + OFF_PQT); ep.Fb = (bf16_t*)(ws + OFF_F);
      if (lat) {
        const int t1 = tn * 2 + hb;
        ep.b = tm >> 3; ep.l0 = (tm & 7) * 256; ep.isctx = 0; ep.row0 = tm * 256;
        if (t1 < 8) { ep.kind = 0; ep.head = t1; }
        else if (t1 < 10) { ep.kind = 1; ep.head = t1 - 8; }
        else if (t1 < 12) { ep.kind = 2; ep.head = t1 - 10; }
        else { ep.kind = 4; ep.fcol = (t1 - 12) * 128; }
      } else { ep.b = tm; ep.l0 = 0; ep.isctx = 1; ep.kind = tn == 0 ? 1 : 2; ep.head = hb; }
    }
    if (lat) gemm_tile2(Hb + (size_t)(tm * 256) * DM, DM, WinT + (size_t)(tn * 256) * DM, DM, DM, shm, e[0], e[1]);
    else     gemm_tile2(HCb + (size_t)(tm * 256) * DM, DM, WinT + (size_t)(1024 + tn * 256) * DM, DM, DM, shm, e[0], e[1]);
  }
  if (G == 256) {
    if (bid < 144) { for (int k = 0; k < 3; ++k) quant_item(p, bid * 3 + k); }
    else { for (int q = 432 + (bid - 144); q < 2048; q += 112) quant_item(p, q); }
  } else { for (int q = bid; q < 2048; q += G) quant_item(p, q); }
  xcd_barrier(xb);

  for (int it = bid; it < 512; it += G) {
    const int g = it >> 7, ab = (it >> 6) & 1, tm = it & 63;
    bf16_t* o = (bf16_t*)(ws + OFF_PQT) + ((size_t)(((tm >> 3) * 4 + g) * 256)) * 4096 + ab * 2048 + (tm & 7) * 256;
    EpiPQT e0{o}, e1{o + (size_t)128 * 4096};
    gemm_tile2<EpiPQT, true>((const bf16_t*)(ws + OFF_F) + (size_t)(tm * 256) * 1024 + g * 256, 1024,
               (const bf16_t*)(ws + OFF_ABT) + (size_t)(g * 512 + ab * 256) * 256, 256, 256, shm, e0, e1);
  }
  xcd_barrier(xb);

  {
    bf16_t* mix = (bf16_t*)(ws + OFF_MIX);
    const int xcd = bid & 7, jj = bid >> 3;
    REPS(3) for (int it = bid; it < 512; it += G) {
      int b, h, qb;
      if (G == 256) { const int rnd = it >> 8, pair = rnd * 8 + xcd; b = pair >> 1; h = (pair & 1) * 4 + (jj >> 3); qb = jj & 7; }
      else { b = it >> 6; h = (it >> 3) & 7; qb = it & 7; }
      const int kvh = h >> 2;
      attn::body((const bf16_t*)(ws + OFF_Q) + ((size_t)((b * 8 + h) * SEQ) + qb * 256) * 128,
                 (const bf16_t*)(ws + OFF_K) + (size_t)((b * 2 + kvh) * LK) * 128,
                 (const bf16_t*)(ws + OFF_V) + (size_t)((b * 2 + kvh) * LK) * 128,
                 mix + (size_t)(b * SEQ + qb * 256) * DM + h * 128, LK, shm);
    }
    float* UW = (float*)(ws + OFF_H);
    REPS(4) for (int it = bid; it < 256; it += G) {
      const int bg = it >> 3, uw = (it >> 2) & 1, tm = it & 3;
      float* o = UW + ((size_t)(uw * 32 + bg) * 1024 + tm * 256) * 256;
      EpiStoreF32 e0{o, 256}, e1{o + 128, 256};
      gemm_tile2((const bf16_t*)(ws + OFF_TTAB) + (size_t)(tm * 256) * 4096 + uw * 2048, 4096,
                 (const bf16_t*)(ws + OFF_PQT) + (size_t)(bg * 256) * 4096 + uw * 2048, 4096, 2048, shm, e0, e1);
    }
    xcd_barrier(xb);
    for (int it = bid; it < 4096 + 1024; it += G) {
      const int tid = otid(), wid = tid >> 6, lane = tid & 63;
      if (it < 4096) {
        const int row = it * 8 + wid, bg = row >> 10, k = row & 1023, b = bg >> 2, g = bg & 3, d = lane * 4;
        const f32x4 u = __builtin_nontemporal_load((const f32x4*)(UW + ((size_t)bg * 1024 + k) * 256 + d)), w = __builtin_nontemporal_load((const f32x4*)(UW + ((size_t)(32 + bg) * 1024 + k) * 256 + d));
        const f32x4 bs = *(const f32x4*)(p.b_fourier + g * 256 + d);
        bf16_t* o = mix + (size_t)(b * SEQ + k) * DM + 1024 + g * 256 + d;
        *(u32x2*)o = (u32x2){cvtpk(u[0] + w[0] + bs[0], u[1] + w[1] + bs[1]), cvtpk(u[2] + w[2] + bs[2], u[3] + w[3] + bs[3])};
        if (k > 0) { bf16_t* o2 = mix + (size_t)(b * SEQ + 2048 - k) * DM + 1024 + g * 256 + d;
          *(u32x2*)o2 = (u32x2){cvtpk(u[0] - w[0] + bs[0], u[1] - w[1] + bs[1]), cvtpk(u[2] - w[2] + bs[2], u[3] - w[3] + bs[3])}; }
      } else {
        const int q = (it - 4096) * 8 + wid, bg = q >> 8, d = q & 255, b = bg >> 2, g = bg & 3;
        const bf16_t* pr = (const bf16_t*)(ws + OFF_PQT) + (size_t)(bg * 256 + d) * 4096 + lane * 8;
        float s = 0.f;
#pragma unroll
        for (int i = 0; i < 4; ++i) { const u32x4 t = *(const u32x4*)(pr + i * 512);
#pragma unroll
          for (int e = 0; e < 4; ++e) s += __uint_as_float(t[e] << 16) - __uint_as_float(t[e] & 0xffff0000u); }
        s = wave_sum(s);
        if (lane == 0) mix[(size_t)(b * SEQ + 1024) * DM + 1024 + g * 256 + d] = f2bf(s + p.b_fourier[g * 256 + d]);
      }
    }
  }
  xcd_barrier(xb);

  REPS(5) for (int it = bid; it < 512; it += G) {
    const int tn = it >> 6, tm = it & 63, b = tm >> 3;
    const size_t o = (size_t)(tm * 256) * DM + tn * 256;
    const float* mb = mod + b * NMOD;
    EpiOutProj e0{p.x + o, mb + 2 * DM + tn * 256, p.out + o, p.g_norm2 + tn * 256, mb + 4 * DM + tn * 256, Hb + o, (float*)(ws + OFF_SSQ) + (size_t)(tm * 256) * 16 + tn * 2};
    EpiOutProj e1{p.x + o + 128, mb + 2 * DM + tn * 256 + 128, p.out + o + 128, p.g_norm2 + tn * 256 + 128, mb + 4 * DM + tn * 256 + 128, Hb + o + 128, (float*)(ws + OFF_SSQ) + (size_t)(tm * 256) * 16 + tn * 2 + 1};
    gemm_tile2((const bf16_t*)(ws + OFF_MIX) + (size_t)(tm * 256) * DM, DM, (const bf16_t*)(ws + OFF_WOUTT) + (size_t)(tn * 256) * DM, DM, DM, shm, e0, e1);
  }
  xcd_barrier(xb);

  REPS(7) for (int it = bid; it < 512; it += G) {
    const int tn = it >> 6, tm = it & 63;
    const float* cvb = (const float*)(ws + OFF_CVEC) + (tm >> 3) * 2048 + tn * 256;
    EpiTopk e0{(unsigned*)(ws + OFF_TOPK), tm * 256, tn * 2, (const float*)(ws + OFF_SSQ), cvb}, e1{(unsigned*)(ws + OFF_TOPK), tm * 256, tn * 2 + 1, (const float*)(ws + OFF_SSQ), cvb + 128};
    gemm_tile2(Hb + (size_t)(tm * 256) * DM, DM, (const bf16_t*)(ws + OFF_WST) + (size_t)(tn * 256) * DM, DM, DM, shm, e0, e1);
  }
  xcd_barrier(xb);

  if ((REPK) == 9) { for (int i_ = 0; i_ < 10; ++i_) xcd_barrier(xb); }
  {
    const int tid = otid(), wid = tid >> 6, lane = tid & 63;
    char* wl = shm + wid * 12800;
    for (int it0 = bid; it0 < 2048; it0 += 8 * G) {
      const int rem = (2048 - it0 + G - 1) / G, ntok = rem < 8 ? rem : 8;
      peer_wave8(p, it0 * 8 + wid, G * 8, ntok, wl, lane);
    }
  }
}

extern "C" void kernel_launch(void* const* d_in, const int* in_sizes, int n_in,
                              void* d_out, int out_size, void* d_ws, size_t ws_size,
                              hipStream_t stream) {
  static int grid_blocks = 0;
  if (!grid_blocks) {
    int dev = 0, cus = 0, per_cu = 0;
    (void)hipGetDevice(&dev);
    (void)hipDeviceGetAttribute(&cus, hipDeviceAttributeMultiprocessorCount, dev);
    (void)hipFuncSetAttribute((const void*)mega, hipFuncAttributeMaxDynamicSharedMemorySize, (int)DYN_LDS);
    (void)hipOccupancyMaxActiveBlocksPerMultiprocessor(&per_cu, mega, NT, DYN_LDS);
    if (per_cu < 1) per_cu = 1;
    grid_blocks = cus * per_cu;
    if (ws_size < WS_END) fprintf(stderr, "workspace too small: %zu < %zu\n", ws_size, (size_t)WS_END);
  }
  Params p{};
  const float** pp = (const float**)&p;
  for (int i = 0; i < 19; ++i) pp[i] = (const float*)d_in[i];
  p.out = (float*)d_out; p.ws = (char*)d_ws;
  (void)hipMemsetAsync((char*)d_ws + OFF_BAR, 0, 16384, stream);
  void* args[] = {&p};
  hipError_t e = hipLaunchCooperativeKernel((void*)mega, dim3(grid_blocks), dim3(NT), args, DYN_LDS, stream);
  if (e != hipSuccess) fprintf(stderr, "cooperative launch failed: %s (grid %d)\n", hipGetErrorString(e), grid_blocks);
}
```
